# Optimizing an MI355X kernel written in HIP

```python
import math
import jax, jax.numpy as jnp
from jax import lax
import numpy as np

D_MODEL = 4096
BATCH = 4
SEQ = 4096
DEPTH = 1

CTX_LEN = 256
GRID_W = 64
A_WIDTH = 2048
A_HEADS = 16
A_HEAD_K = 128
A_HEAD_V = A_WIDTH // A_HEADS
A_FDIM = A_HEADS * A_HEAD_K
SCAN_CHUNK = 64
B_WIDTH = 2048
B_GROUPS = 16
B_GROUP_CH = B_WIDTH // B_GROUPS
MIX_CHUNK = 128
D_FF = 4 * D_MODEL
N_MOD = 6
ALPHA = (2.0 * DEPTH) ** 0.25
BETA = (8.0 * DEPTH) ** -0.25
LN_EPS = 1e-6
POS_BASE = 10000.0
IN_SIZES = (A_FDIM, A_WIDTH, A_FDIM, A_FDIM, A_WIDTH, B_WIDTH, B_WIDTH, D_MODEL, D_MODEL)
N_IN = sum(IN_SIZES)

kernel_name = "hybrid_hgrn2_chunkmlp_dit_block"


def _layernorm(x, g=None, b=None):
    xf = x.astype(jnp.float32)
    mu = jnp.mean(xf, axis=-1, keepdims=True)
    xc = xf - mu
    y = xc * lax.rsqrt(jnp.mean(xc * xc, axis=-1, keepdims=True) + LN_EPS)
    if g is not None:
        y = y * g.astype(jnp.float32) + b.astype(jnp.float32)
    return y.astype(x.dtype)


def _adaln(x, shift, scale):
    return _layernorm(x) * (1.0 + scale) + shift


def _sincos_2d(rows, cols, dim):
    quarter = dim // 4
    omega = 1.0 / (POS_BASE ** (jnp.arange(quarter, dtype=jnp.float32) / quarter))
    r, cc = jnp.meshgrid(jnp.arange(rows, dtype=jnp.float32), jnp.arange(cols, dtype=jnp.float32), indexing="ij")
    def emb(p):
        a = p.reshape(-1)[:, None] * omega[None, :]
        return jnp.concatenate([jnp.sin(a), jnp.cos(a)], axis=-1)
    return jnp.concatenate([emb(r), emb(cc)], axis=-1)


def _in_proj(h, w_in):
    idx, acc = [], 0
    for s in IN_SIZES[:-1]:
        acc += s
        idx.append(acc)
    return jnp.split(h @ w_in, idx, axis=-1)


def _rec_inputs(q, i, zf, zb, lb_f, lb_b):
    bn, t, _ = q.shape
    def heads(a, d):
        return a.astype(jnp.float32).reshape(bn, t, A_HEADS, d)
    qh = heads(jax.nn.silu(q), A_HEAD_K) * (A_HEAD_K ** -0.5)
    vh = heads(i, A_HEAD_V)
    def gate(z, lb):
        z = z.astype(jnp.float32)
        logf = jnp.log(lb + (1.0 - lb) * jax.nn.sigmoid(z))
        k = (1.0 - lb) * jax.nn.sigmoid(-z)
        return heads(k, A_HEAD_K), heads(logf, A_HEAD_K)
    kf, lff = gate(zf, lb_f)
    kb, lfb = gate(zb, lb_b)
    return qh, vh, kf, lff, kb, lfb


def _chunk_scan(q, k, v, logf, s0):
    bn, t, h, _ = q.shape
    n = t // SCAN_CHUNK
    def to_chunks(a):
        return a.reshape(bn, n, SCAN_CHUNK, h, a.shape[-1]).transpose(1, 0, 3, 2, 4)
    mask = jnp.tril(jnp.ones((SCAN_CHUNK, SCAN_CHUNK), dtype=bool))
    def step(s, inp):
        qc, kc, vc, lc = inp
        b = jnp.cumsum(lc, axis=2)
        diff = b[:, :, :, None, :] - b[:, :, None, :, :]
        decay = jnp.exp(jnp.where(mask[:, :, None], diff, -jnp.inf))
        att = jnp.einsum("bhtsk,bhsk->bhts", qc[:, :, :, None, :] * decay, kc)
        o = jnp.einsum("bhts,bhsv->bhtv", att, vc) + jnp.einsum("bhtk,bhkv->bhtv", qc * jnp.exp(b), s)
        b_last = b[:, :, -1:, :]
        s_new = jnp.exp(b_last[:, :, 0, :])[..., None] * s + jnp.einsum("bhsk,bhsv->bhkv", kc * jnp.exp(b_last - b), vc)
        return s_new, o
    s_fin, o = lax.scan(step, s0, (to_chunks(q), to_chunks(k), to_chunks(v), to_chunks(logf)))
    o = o.transpose(1, 0, 3, 2, 4).reshape(bn, t, h, v.shape[-1])
    return s_fin, o


def _bidir(qh, vh, kf, lff, kb, lfb, s_f, s_b):
    flip = lambda a: jnp.flip(a, axis=1)
    sf, of = _chunk_scan(qh, kf, vh, lff, s_f)
    sb, ob = _chunk_scan(flip(qh), flip(kb), flip(vh), flip(lfb), s_b)
    return sf, sb, of + flip(ob)


def _hgrn2_readout(o, g, gain):
    bn, t = o.shape[0], o.shape[1]
    o = o * lax.rsqrt(jnp.mean(o * o, axis=-1, keepdims=True) + LN_EPS) * gain.astype(jnp.float32)
    return (o.reshape(bn, t, A_WIDTH) * jax.nn.silu(g.astype(jnp.float32))).astype(g.dtype)


def _chunk_mix(u, v, v_g, v_b, w_s, b_s):
    bn, t, _ = v.shape
    n = t // MIX_CHUNK
    vn = _layernorm(v, v_g, v_b).reshape(bn, n, MIX_CHUNK, B_GROUPS, B_GROUP_CH)
    mixed = jnp.einsum("gts,bnsgc->bntgc", w_s, vn) + b_s.T[None, None, :, :, None]
    return u * mixed.reshape(bn, t, B_WIDTH)


def _stream_update(x, p, o_rec, mod, a_norm_g, v_norm_g, v_norm_b, w_s, b_s, w_proj_a, w_proj_b,
                   w_out, ln1_g, ln1_b, w_ff1, w_ff2, ln2_g, ln2_b):
    y_a = _hgrn2_readout(o_rec, p[4], a_norm_g)
    y_b = _chunk_mix(p[5], p[6], v_norm_g, v_norm_b, w_s, b_s)
    merged = jax.nn.sigmoid(p[7]) * (y_a @ w_proj_a) + jax.nn.sigmoid(p[8]) * (y_b @ w_proj_b)
    x = _layernorm(ALPHA * x + mod[2] * (merged @ w_out), ln1_g, ln1_b)
    h = _adaln(x, mod[3], mod[4])
    ff = jnp.square(jax.nn.relu(h @ w_ff1)) @ w_ff2
    return _layernorm(ALPHA * x + mod[5] * ff, ln2_g, ln2_b)


def setup_inputs(seed: int = 0) -> dict:
    key = jax.random.key(seed)
    ks = jax.random.split(key, 24)
    f32 = jnp.float32
    nrm = lambda k, shape, s: jax.random.normal(k, shape, f32) * s
    return {
        "x": nrm(ks[0], (BATCH, SEQ, D_MODEL), 1.0),
        "c": nrm(ks[1], (BATCH, D_MODEL), 1.0),
        "ctx": nrm(ks[2], (BATCH, CTX_LEN, D_MODEL), 1.0),
        "c_ctx": nrm(ks[3], (D_MODEL,), 1.0),
        "w_ada": nrm(ks[4], (DEPTH, D_MODEL, N_MOD * D_MODEL), 0.5 * D_MODEL ** -0.5),
        "b_ada": nrm(ks[5], (DEPTH, N_MOD * D_MODEL), 0.02),
        "w_in": nrm(ks[6], (DEPTH, D_MODEL, N_IN), D_MODEL ** -0.5),
        "lb_logits": nrm(ks[7], (2, DEPTH + 1, A_FDIM), 0.5),
        "a_norm_g": 1.0 + nrm(ks[8], (DEPTH, A_HEAD_V), 0.02),
        "w_proj_a": nrm(ks[9], (DEPTH, A_WIDTH, D_MODEL), BETA * A_WIDTH ** -0.5),
        "v_norm_g": 1.0 + nrm(ks[10], (DEPTH, B_WIDTH), 0.02),
        "v_norm_b": nrm(ks[11], (DEPTH, B_WIDTH), 0.02),
        "w_s": nrm(ks[12], (DEPTH, B_GROUPS, MIX_CHUNK, MIX_CHUNK), MIX_CHUNK ** -0.5),
        "b_s": 1.0 + nrm(ks[13], (DEPTH, B_GROUPS, MIX_CHUNK), 0.02),
        "w_proj_b": nrm(ks[14], (DEPTH, B_WIDTH, D_MODEL), BETA * B_WIDTH ** -0.5),
        "w_out": nrm(ks[15], (DEPTH, D_MODEL, D_MODEL), BETA * D_MODEL ** -0.5),
        "ln1_g": 1.0 + nrm(ks[16], (DEPTH, D_MODEL), 0.02),
        "ln1_b": nrm(ks[17], (DEPTH, D_MODEL), 0.02),
        "w_ff1": nrm(ks[18], (DEPTH, D_MODEL, D_FF), BETA * D_MODEL ** -0.5),
        "w_ff2": nrm(ks[19], (DEPTH, D_FF, D_MODEL), BETA * D_FF ** -0.5),
        "ln2_g": 1.0 + nrm(ks[20], (DEPTH, D_MODEL), 0.02),
        "ln2_b": nrm(ks[21], (DEPTH, D_MODEL), 0.02),
    }


def reference(x, c, ctx, c_ctx, w_ada, b_ada, w_in, lb_logits, a_norm_g, w_proj_a, v_norm_g, v_norm_b,
              w_s, b_s, w_proj_b, w_out, ln1_g, ln1_b, w_ff1, w_ff2, ln2_g, ln2_b):
    bn, t, _ = x.shape
    rows = t // GRID_W
    x = x + _sincos_2d(rows, GRID_W, D_MODEL).astype(x.dtype)[None]
    xc = ctx
    lb_all = jnp.cumsum(jax.nn.softmax(lb_logits.astype(jnp.float32), axis=1), axis=1)
    zero_state = jnp.zeros((bn, A_HEADS, A_HEAD_K, A_HEAD_V), jnp.float32)
    for l in range(DEPTH):
        last = l == DEPTH - 1
        mx = jnp.split((jax.nn.silu(c) @ w_ada[l] + b_ada[l])[:, None, :], N_MOD, axis=-1)
        mc = jnp.split((jax.nn.silu(c_ctx) @ w_ada[l] + b_ada[l])[None, None, :], N_MOD, axis=-1)
        lb_f, lb_b = lb_all[0, l], lb_all[1, l]
        px = _in_proj(_adaln(x, mx[0], mx[1]), w_in[l])
        pc = _in_proj(_adaln(xc, mc[0], mc[1]), w_in[l])
        s_f, s_b, o_c = _bidir(*_rec_inputs(pc[0], pc[1], pc[2], pc[3], lb_f, lb_b), zero_state, zero_state)
        _, _, o_x = _bidir(*_rec_inputs(px[0], px[1], px[2], px[3], lb_f, lb_b), s_f, s_b)
        lw = (a_norm_g[l], v_norm_g[l], v_norm_b[l], w_s[l], b_s[l], w_proj_a[l], w_proj_b[l], w_out[l],
              ln1_g[l], ln1_b[l], w_ff1[l], w_ff2[l], ln2_g[l], ln2_b[l])
        x_new = _stream_update(x, px, o_x, mx, *lw)
        if not last:
            xc = _stream_update(xc, pc, o_c, mc, *lw)
        x = x_new
    return x
```

```cpp
#include <hip/hip_runtime.h>
#include <cstdio>
#include <cstdint>

#ifndef SCAN_NAIVE
#define SCAN_NAIVE 0
#endif
#ifndef MIX_NAIVE
#define MIX_NAIVE 0
#endif
#ifndef PG8_AUX
#define PG8_AUX 0
#endif
#ifndef FF2_WGM
#define FF2_WGM 2
#endif
#ifndef FP8_T0
#define FP8_T0 0
#endif
#ifndef BF_T0
#define BF_T0 0
#endif
#ifndef I8_GV
#define I8_GV 1
#endif
#ifndef I8_U
#define I8_U 1
#endif
#ifndef PROBE_DUP
#define PROBE_DUP -1
#endif
#define REPS(k) for (int rep_ = 0; rep_ < ((PROBE_DUP == (k)) ? 2 : 1); ++rep_)
#ifndef MK_N_LAUNCHES
#define MK_N_LAUNCHES 1
#endif

namespace pg8 {
#define PG8_LAS __attribute__((address_space(3)))
typedef unsigned short bf16_t;
typedef short bf16x8 __attribute__((ext_vector_type(8)));
typedef float f32x4 __attribute__((ext_vector_type(4)));
typedef unsigned u32x4 __attribute__((ext_vector_type(4)));
typedef int v4i32 __attribute__((ext_vector_type(4)));
constexpr int BM = 256, BK = 64, HALF = 128, HTB = HALF * BK * 2, STAGE_BYTES = 8 * HTB, NXCD = 8, WGM = 8;

__host__ __device__ __forceinline__ int lds_byte(int r, int c) { const int st = (r >> 4) * 2 + (c >> 5), rr = r & 15, cc = c & 31, ob = rr * 64 + cc * 2; return st * 1024 + (ob ^ (((ob >> 9) & 1) << 5)); }
__host__ __device__ __forceinline__ void stage_rc(int b, int& R, int& C) { const int st = b / 1024, sb = b % 1024, swz = sb ^ (((sb >> 9) & 1) << 5); R = (st >> 1) * 16 + swz / 64; C = (st & 1) * 32 + (swz % 64) / 2; }
__host__ __device__ __forceinline__ int perm32(int rho) { const int n = rho >> 4, i = rho & 15; return 8 * (i >> 2) + 4 * n + (i & 3); }

struct Unit { int pm, pn; };
struct Operand { const bf16_t* p; unsigned rowpitch; size_t kstep, hstep, tstep; };
__host__ __device__ __forceinline__ size_t tl_off(int r, int c, int ldk) { return ((size_t)(r >> 8) * (size_t)(ldk >> 6) + (size_t)(c >> 6)) * 16384 + (size_t)(((r >> 7) & 1) * 8192 + (lds_byte(r & 127, c & 63) >> 1)); }
__host__ __device__ __forceinline__ int invperm32(int x) { return 16 * ((x >> 2) & 1) + 4 * (x >> 3) + (x & 3); }
__host__ __device__ __forceinline__ size_t tl_off_b(int n, int c, int ldk, bool perm) { return tl_off(perm ? ((n & ~31) + invperm32(n & 31)) : n, c, ldk); }
__host__ __device__ __forceinline__ Operand tiled(const bf16_t* base, int ldk, int col0 = 0) { Operand o; o.p = base + (size_t)(col0 >> 6) * 16384; o.rowpitch = 0; o.kstep = 32768; o.hstep = 16384; o.tstep = (size_t)(ldk >> 6) * 32768; return o; }
__host__ __device__ __forceinline__ Operand rowmajor(const bf16_t* base, int ld) { Operand o; o.p = base; o.rowpitch = (unsigned)ld; o.kstep = 128; o.hstep = (size_t)128 * ld * 2; o.tstep = (size_t)256 * ld * 2; return o; }
struct Gemm { Operand A, B; int K; };

struct StaticOrder {
    int nM, nN, nwg, G, c, nex, exM, wgm, pnoff = 0, gap_at = 1 << 30, gap_n = 0, expn0 = 0;
    __device__ void init(int nM_, int nN_, int G_, int c_, int exM_ = 0, int exN_ = 0, int wgm_ = WGM) { nM = nM_; nN = nN_; nwg = nM * nN; G = G_; c = c_; exM = exM_; nex = exM_ * exN_; wgm = wgm_; }
    __device__ bool next(int i, Unit& u) const {
        const long L = (long)i * G + c; if (L >= nwg + nex) return false;
        if (L >= nwg) { const int idx = (int)L - nwg; u.pm = nM + idx % exM; u.pn = idx / exM + expn0; return true; }
        int wgid = (int)L; { const int q = nwg / NXCD, r = nwg % NXCD, xcd = wgid % NXCD, off = wgid / NXCD; wgid = (xcd < r ? xcd * (q + 1) : r * (q + 1) + (xcd - r) * q) + off; }
        const int nig = wgm * nN, gid = wgid / nig, fm = gid * wgm, gsz = (nM - fm) < wgm ? (nM - fm) : wgm;
        u.pm = fm + ((wgid % nig) % gsz); u.pn = (wgid % nig) / gsz + pnoff; if (u.pn >= gap_at) u.pn += gap_n; return true;
    }
    __device__ __forceinline__ void a_ready(const Unit&) const {}
    __device__ __forceinline__ void done(const Unit&) const {}
};

__device__ __forceinline__ unsigned cvt_pk_bf16(float lo, float hi) { unsigned r; asm volatile("v_cvt_pk_bf16_f32 %0, %1, %2" : "=v"(r) : "v"(lo), "v"(hi)); return r; }
__device__ __forceinline__ float bflo(unsigned w) { return __uint_as_float(w << 16); }
__device__ __forceinline__ float bfhi(unsigned w) { return __uint_as_float(w & 0xffff0000u); }
__device__ __forceinline__ float sigm(float v) { return __builtin_amdgcn_rcpf(1.0f + __expf(-v)); }

constexpr size_t SZ4 = (size_t)17408 * 2048, SZ3 = (size_t)16384 * 2048, SZG = (size_t)16384 * 4096;
struct EpiInProj {
    static constexpr bool PERM = true, AFTER_DRAIN = false;
    bf16_t* P;
    __device__ __forceinline__ void operator()(const f32x4 (&acc)[2][2][4][2], const Unit& u, int wr, int wc, int fr, int fq) const {
        const int seg = u.pn >> 3; bf16_t* base = P + 4 * SZ4 + (size_t)seg * SZ3;
        const int row0 = u.pm * BM + wr * 64 + fr, col0 = (u.pn & 7) * 256 + wc * 32 + 8 * fq;
#pragma unroll
        for (int ai = 0; ai < 2; ++ai)
#pragma unroll
            for (int m = 0; m < 4; ++m) { bf16_t* rowp = base + (size_t)(row0 + ai * HALF + m * 16) * 2048 + col0;
#pragma unroll
                for (int bj = 0; bj < 2; ++bj) { f32x4 v0 = acc[ai][bj][m][0], v1 = acc[ai][bj][m][1];
                    if (seg == 0) {
#pragma unroll
                        for (int j = 0; j < 4; ++j) { v0[j] = v0[j] * sigm(v0[j]); v1[j] = v1[j] * sigm(v1[j]); } }
                    u32x4 w; w.x = cvt_pk_bf16(v0[0], v0[1]); w.y = cvt_pk_bf16(v0[2], v0[3]); w.z = cvt_pk_bf16(v1[0], v1[1]); w.w = cvt_pk_bf16(v1[2], v1[3]);
                    *(u32x4*)(rowp + bj * HALF) = w; } }
    }
};
struct EpiInProj8 {
    static constexpr bool PERM = true, AFTER_DRAIN = false;
    bf16_t* P; const PG8_LAS float* scs;
    __device__ __forceinline__ void operator()(const f32x4 (&acc)[2][2][4][2], const Unit& u, int wr, int wc, int fr, int fq) const {
        const int row0 = u.pm * BM + wr * 64 + fr, cl0 = wc * 32 + 8 * fq; const PG8_LAS float* sa = scs + wr * 64 + fr - row0;
        f32x4 sbv[2][2];
#pragma unroll
        for (int bj = 0; bj < 2; ++bj) { sbv[bj][0] = *(const PG8_LAS f32x4*)(scs + 256 + cl0 + bj * HALF); sbv[bj][1] = *(const PG8_LAS f32x4*)(scs + 256 + cl0 + bj * HALF + 4); }
        if (u.pn >= 32 && u.pn < 64) {
            unsigned long long* G8 = (unsigned long long*)(P + 4 * SZ4 + 3 * SZ3) + ((size_t)(((u.pn - 32) >> 4) * 64 + u.pm) * 16 + ((u.pn - 32) & 15)) * 16 * 512 + threadIdx.x;
#pragma unroll
            for (int ai = 0; ai < 2; ++ai)
#pragma unroll
                for (int m = 0; m < 4; ++m) { const float nsr = sa[row0 + ai * HALF + m * 16] * -1.4426950408889634f;
#pragma unroll
                    for (int bj = 0; bj < 2; ++bj) { const v4i32 i0 = __builtin_bit_cast(v4i32, acc[ai][bj][m][0]), i1 = __builtin_bit_cast(v4i32, acc[ai][bj][m][1]); unsigned lo = 0u, hi = 0u;
#pragma unroll
                        for (int j = 0; j < 4; ++j) {
                            const float e0 = __builtin_amdgcn_exp2f((float)i0[j] * (nsr * sbv[bj][0][j])), e1 = __builtin_amdgcn_exp2f((float)i1[j] * (nsr * sbv[bj][1][j]));
                            const float r0 = __builtin_rintf(fmaxf(__builtin_amdgcn_rcpf(e0 * (1.0f / 255.0f) + (1.0f / 255.0f)), 1.0f)), r1 = __builtin_rintf(fmaxf(__builtin_amdgcn_rcpf(e1 * (1.0f / 255.0f) + (1.0f / 255.0f)), 1.0f));
                            lo = __builtin_amdgcn_cvt_pk_u8_f32(r0, j, lo); hi = __builtin_amdgcn_cvt_pk_u8_f32(r1, j, hi); }
                        G8[(size_t)(ai * 8 + m * 2 + bj) * 512] = ((unsigned long long)hi << 32) | lo; } }
            return; }
        const int seg = u.pn >> 3; bf16_t* base = seg < 4 ? P + (size_t)seg * SZ4 : P + 4 * SZ4 + (size_t)(seg == 8 ? 0 : (seg == 9 ? 2 : 1)) * SZ3;
        const int col0 = (u.pn & 7) * 256 + cl0;
#pragma unroll
        for (int ai = 0; ai < 2; ++ai)
#pragma unroll
            for (int m = 0; m < 4; ++m) { const int rr = row0 + ai * HALF + m * 16; const float sr = sa[rr]; bf16_t* rowp = base + (size_t)rr * 2048 + col0;
#pragma unroll
                for (int bj = 0; bj < 2; ++bj) { const v4i32 i0 = __builtin_bit_cast(v4i32, acc[ai][bj][m][0]), i1 = __builtin_bit_cast(v4i32, acc[ai][bj][m][1]); float v[8];
#pragma unroll
                    for (int j = 0; j < 4; ++j) { v[j] = (float)i0[j] * (sr * sbv[bj][0][j]); v[4 + j] = (float)i1[j] * (sr * sbv[bj][1][j]); }
                    if (seg == 0 || seg == 8) { const float scq = seg == 0 ? 0.08838834764831845f : 1.0f;
#pragma unroll
                        for (int j = 0; j < 8; ++j) v[j] = v[j] * sigm(v[j]) * scq; }
                    u32x4 w; w.x = cvt_pk_bf16(v[0], v[1]); w.y = cvt_pk_bf16(v[2], v[3]); w.z = cvt_pk_bf16(v[4], v[5]); w.w = cvt_pk_bf16(v[6], v[7]);
                    *(u32x4*)(rowp + bj * HALF) = w; } }
    }
};
__device__ __forceinline__ void gate8(unsigned long long w, float (&g)[8]) { const unsigned lo = (unsigned)w, hi = (unsigned)(w >> 32);
    g[0] = (float)(lo & 255u); g[1] = (float)((lo >> 8) & 255u); g[2] = (float)((lo >> 16) & 255u); g[3] = (float)(lo >> 24); g[4] = (float)(hi & 255u); g[5] = (float)((hi >> 8) & 255u); g[6] = (float)((hi >> 16) & 255u); g[7] = (float)(hi >> 24);
#pragma unroll
    for (int j = 0; j < 8; ++j) g[j] *= (1.0f / 255.0f); }
__device__ __forceinline__ const char* gate_tile(const bf16_t* Pg, int gate, const Unit& u) { return (const char*)Pg + ((size_t)(gate * 64 + u.pm) * 16 + u.pn) * (16 * 512 * 8); }
__device__ __forceinline__ unsigned long long gate_ld(const char* tile, int it, unsigned toff) { return *(const __attribute__((address_space(1))) unsigned long long*)(tile + it * 4096 + toff); }
template <bool ADD> struct EpiMerge {
    static constexpr bool PERM = true, AFTER_DRAIN = false;
    const bf16_t* Pg; int gate; bf16_t* O;
    __device__ __forceinline__ void operator()(const f32x4 (&acc)[2][2][4][2], const Unit& u, int wr, int wc, int fr, int fq) const {
        const int row0 = u.pm * BM + wr * 64 + fr, col0 = u.pn * BM + wc * 32 + 8 * fq;
        const char* G8 = gate_tile(Pg, gate, u); const unsigned toff = threadIdx.x * 8u;
        u32x4 gq[8];
#pragma unroll
        for (int it = 0; it < 8; ++it) { const unsigned long long a_ = gate_ld(G8, 2 * it, toff), b_ = gate_ld(G8, 2 * it + 1, toff); gq[it] = (u32x4){(unsigned)a_, (unsigned)(a_ >> 32), (unsigned)b_, (unsigned)(b_ >> 32)}; }
        asm volatile("" : "+v"(gq[0]), "+v"(gq[1]), "+v"(gq[2]), "+v"(gq[3]), "+v"(gq[4]), "+v"(gq[5]), "+v"(gq[6]), "+v"(gq[7]));
#pragma unroll
        for (int ai = 0; ai < 2; ++ai)
#pragma unroll
            for (int m = 0; m < 4; ++m) { const int rr = row0 + ai * HALF + m * 16;
#pragma unroll
                for (int bj = 0; bj < 2; ++bj) { const f32x4 v0 = acc[ai][bj][m][0], v1 = acc[ai][bj][m][1];
                    bf16_t* const op = O + tl_off(rr, col0 + bj * HALF, 4096);
                    float g[8]; { const u32x4 q_ = gq[(ai * 8 + m * 2 + bj) >> 1]; gate8(bj ? (((unsigned long long)q_.w << 32) | q_.z) : (((unsigned long long)q_.y << 32) | q_.x), g); }
                    float o[8] = {g[0] * v0[0], g[1] * v0[1], g[2] * v0[2], g[3] * v0[3], g[4] * v1[0], g[5] * v1[1], g[6] * v1[2], g[7] * v1[3]};
                    if (ADD) { const u32x4 p = *(const u32x4*)op;
                        o[0] += bflo(p.x); o[1] += bfhi(p.x); o[2] += bflo(p.y); o[3] += bfhi(p.y); o[4] += bflo(p.z); o[5] += bfhi(p.z); o[6] += bflo(p.w); o[7] += bfhi(p.w); }
                    u32x4 w; w.x = cvt_pk_bf16(o[0], o[1]); w.y = cvt_pk_bf16(o[2], o[3]); w.z = cvt_pk_bf16(o[4], o[5]); w.w = cvt_pk_bf16(o[6], o[7]);
                    *(u32x4*)op = w; } }
    }
};
struct NoMid { static constexpr bool ACTIVE = false; __device__ __forceinline__ void operator()(f32x4 (&)[2][2][4][2], const Unit&, int, int, int, int) const {} };
struct MidScales {
    static constexpr bool ACTIVE = true;
    const float* sa; const float* sb; PG8_LAS unsigned char* scs;
    __device__ __forceinline__ void operator()(f32x4 (&)[2][2][4][2], const Unit& u, int wr, int wc, int fr, int fq) const {
        const int wid = wr * 4 + wc, lane = fq * 16 + fr;
        const float* g = wid < 4 ? sa + (size_t)u.pm * BM + wid * 64 + lane : sb + (size_t)u.pn * BM + (wid - 4) * 64 + lane;
        __builtin_amdgcn_global_load_lds((const unsigned*)g, (PG8_LAS unsigned*)(scs + wid * 256), 4, 0, 0);
    }
};
struct MidRatio {
    static constexpr bool ACTIVE = true;
    const bf16_t* Pg;
    __device__ __forceinline__ void operator()(f32x4 (&acc)[2][2][4][2], const Unit& u, int wr, int wc, int fr, int fq) const {
        unsigned toff = threadIdx.x * 8u; asm volatile("" : "+v"(toff));
        const char* GA = gate_tile(Pg, 0, u); const char* GB = gate_tile(Pg, 1, u); asm volatile("" : "+s"(GA), "+s"(GB));
        u32x4 gw[16];
#pragma unroll
        for (int it = 0; it < 16; ++it) { const unsigned long long a_ = gate_ld(GA, it, toff), b_ = gate_ld(GB, it, toff); gw[it] = (u32x4){(unsigned)a_, (unsigned)(a_ >> 32), (unsigned)b_, (unsigned)(b_ >> 32)}; }
        asm volatile("" : "+v"(gw[0]), "+v"(gw[1]), "+v"(gw[2]), "+v"(gw[3]), "+v"(gw[4]), "+v"(gw[5]), "+v"(gw[6]), "+v"(gw[7]), "+v"(gw[8]), "+v"(gw[9]), "+v"(gw[10]), "+v"(gw[11]), "+v"(gw[12]), "+v"(gw[13]), "+v"(gw[14]), "+v"(gw[15]));
#pragma unroll
        for (int ai = 0; ai < 2; ++ai)
#pragma unroll
            for (int m = 0; m < 4; ++m)
#pragma unroll
                for (int bj = 0; bj < 2; ++bj) { float a[8], b[8]; { const u32x4 g_ = gw[ai * 8 + m * 2 + bj]; gate8(((unsigned long long)g_.y << 32) | g_.x, a); gate8(((unsigned long long)g_.w << 32) | g_.z, b); }
                    f32x4& v0 = acc[ai][bj][m][0]; f32x4& v1 = acc[ai][bj][m][1];
                    v0[0] *= a[0] * __builtin_amdgcn_rcpf(b[0]); v0[1] *= a[1] * __builtin_amdgcn_rcpf(b[1]); v0[2] *= a[2] * __builtin_amdgcn_rcpf(b[2]); v0[3] *= a[3] * __builtin_amdgcn_rcpf(b[3]);
                    v1[0] *= a[4] * __builtin_amdgcn_rcpf(b[4]); v1[1] *= a[5] * __builtin_amdgcn_rcpf(b[5]); v1[2] *= a[6] * __builtin_amdgcn_rcpf(b[6]); v1[3] *= a[7] * __builtin_amdgcn_rcpf(b[7]); }
    }
};
template <int MODE> struct EpiResid {
    static constexpr bool PERM = false, AFTER_DRAIN = false;
    const float* X; const float* mod; float alpha; float* Xo; const float* E; const float* st; const float* g; const float* bb;
    __device__ __forceinline__ void operator()(const f32x4 (&acc)[2][2][4][2], const Unit& u, int wr, int wc, int fr, int fq) const {
        const int row0 = u.pm * BM + wr * 64 + fr, col0 = u.pn * BM + wc * 32 + 4 * fq;
        const float* mrow = mod + (size_t)(u.pm >> 4) * 24576 + col0;
        f32x4 mv[2][2], gv[2][2], bv[2][2];
#pragma unroll
        for (int bj = 0; bj < 2; ++bj)
#pragma unroll
            for (int n = 0; n < 2; ++n) { mv[bj][n] = *(const f32x4*)(mrow + bj * HALF + n * 16);
                if (MODE == 2) { gv[bj][n] = *(const f32x4*)(g + col0 + bj * HALF + n * 16); bv[bj][n] = *(const f32x4*)(bb + col0 + bj * HALF + n * 16); } }
#pragma unroll
        for (int ai = 0; ai < 2; ++ai)
#pragma unroll
            for (int mp = 0; mp < 2; ++mp) {
                f32x4 xv[2][2][2], ev[2][2][2]; float mu[2] = {0.f, 0.f}, rs[2] = {1.f, 1.f};
#pragma unroll
                for (int mm = 0; mm < 2; ++mm) { const int rr = row0 + ai * HALF + (2 * mp + mm) * 16; const float* rowp = X + (size_t)rr * 4096 + col0;
                    const float* erow = nullptr;
                    if (MODE == 1) { const int t = rr & 4095; erow = E + (size_t)((u.pn < 8) ? (t >> 6) : (t & 63)) * 2048 + (col0 & 2047); }
                    if (MODE == 2) { mu[mm] = st[2 * rr]; rs[mm] = st[2 * rr + 1]; }
#pragma unroll
                    for (int bj = 0; bj < 2; ++bj)
#pragma unroll
                        for (int n = 0; n < 2; ++n) { xv[mm][bj][n] = *(const f32x4*)(rowp + bj * HALF + n * 16); if (MODE == 1) ev[mm][bj][n] = *(const f32x4*)(erow + bj * HALF + n * 16); } }
                asm volatile("" : "+v"(xv[0][0][0]), "+v"(xv[0][0][1]), "+v"(xv[0][1][0]), "+v"(xv[0][1][1]), "+v"(xv[1][0][0]), "+v"(xv[1][0][1]), "+v"(xv[1][1][0]), "+v"(xv[1][1][1]));
                if (MODE == 1) asm volatile("" : "+v"(ev[0][0][0]), "+v"(ev[0][0][1]), "+v"(ev[0][1][0]), "+v"(ev[0][1][1]), "+v"(ev[1][0][0]), "+v"(ev[1][0][1]), "+v"(ev[1][1][0]), "+v"(ev[1][1][1]));
                if (MODE == 2) asm volatile("" : "+v"(mu[0]), "+v"(mu[1]), "+v"(rs[0]), "+v"(rs[1]));
#pragma unroll
                for (int mm = 0; mm < 2; ++mm) { const int m = 2 * mp + mm; const int rr = row0 + ai * HALF + m * 16; float* rowo = Xo + (size_t)rr * 4096 + col0;
#pragma unroll
                    for (int bj = 0; bj < 2; ++bj)
#pragma unroll
                        for (int n = 0; n < 2; ++n) { f32x4 x_ = xv[mm][bj][n];
                            if (MODE == 1) x_ += ev[mm][bj][n];
                            if (MODE == 2) x_ = (x_ - mu[mm]) * rs[mm] * gv[bj][n] + bv[bj][n];
                            *(f32x4*)(rowo + bj * HALF + n * 16) = x_ * alpha + mv[bj][n] * acc[ai][bj][m][n]; } } }
    }
};
struct MidLn {
    static constexpr bool ACTIVE = true;
    const float* mod; const float* g; const float* bb; const float* st; PG8_LAS unsigned char* slot;
    __device__ __forceinline__ void operator()(f32x4 (&)[2][2][4][2], const Unit& u, int wr, int wc, int fr, int fq) const {
        const int wid = wr * 4 + wc, lane = fq * 16 + fr;
        if (wid < 5) { const float* src = wid == 0 ? mod + (size_t)(u.pm >> 4) * 24576 + u.pn * BM : (wid == 1 ? g + u.pn * BM : (wid == 2 ? bb + u.pn * BM : st + (size_t)u.pm * BM * 2 + (wid - 3) * 256));
            __builtin_amdgcn_global_load_lds((const unsigned*)(src + lane * 4), (PG8_LAS unsigned*)(slot + wid * 1024), 16, 0, 0); }
    }
};
struct EpiResidLn {
    static constexpr bool PERM = false, AFTER_DRAIN = false;
    const float* X; float alpha; float* Xo; const PG8_LAS float* slot;
    __device__ __forceinline__ void operator()(const f32x4 (&acc)[2][2][4][2], const Unit& u, int wr, int wc, int fr, int fq) const {
        const int row0 = u.pm * BM + wr * 64 + fr, col0 = u.pn * BM + wc * 32 + 4 * fq;
#pragma unroll
        for (int ai = 0; ai < 2; ++ai) {
            f32x4 xv[4][2][2];
#pragma unroll
            for (int m = 0; m < 4; ++m) { const float* rowp = X + (size_t)(row0 + ai * HALF + m * 16) * 4096 + col0;
#pragma unroll
                for (int bj = 0; bj < 2; ++bj)
#pragma unroll
                    for (int n = 0; n < 2; ++n) xv[m][bj][n] = *(const f32x4*)(rowp + bj * HALF + n * 16); }
            asm volatile("" : "+v"(xv[0][0][0]), "+v"(xv[0][0][1]), "+v"(xv[0][1][0]), "+v"(xv[0][1][1]), "+v"(xv[1][0][0]), "+v"(xv[1][0][1]), "+v"(xv[1][1][0]), "+v"(xv[1][1][1]),
                              "+v"(xv[2][0][0]), "+v"(xv[2][0][1]), "+v"(xv[2][1][0]), "+v"(xv[2][1][1]), "+v"(xv[3][0][0]), "+v"(xv[3][0][1]), "+v"(xv[3][1][0]), "+v"(xv[3][1][1]));
#pragma unroll
            for (int m = 0; m < 4; ++m) { int lcol = wc * 32 + 4 * fq, lrow = wr * 64 + fr + ai * HALF + m * 16; asm volatile("" : "+v"(lcol), "+v"(lrow));
                float* rowo = Xo + (size_t)(row0 + ai * HALF + m * 16) * 4096 + col0;
                const float mu = slot[768 + 2 * lrow], rs = slot[768 + 2 * lrow + 1];
#pragma unroll
                for (int bj = 0; bj < 2; ++bj)
#pragma unroll
                    for (int n = 0; n < 2; ++n) { const int c = lcol + bj * HALF + n * 16;
                        const f32x4 mv = *(const PG8_LAS f32x4*)(slot + c), gv = *(const PG8_LAS f32x4*)(slot + 256 + c), bv = *(const PG8_LAS f32x4*)(slot + 512 + c);
                        const f32x4 x_ = (xv[m][bj][n] - mu) * rs * gv + bv;
                        *(f32x4*)(rowo + bj * HALF + n * 16) = x_ * alpha + mv * acc[ai][bj][m][n]; } } }
    }
};
struct EpiRelu2 {
    static constexpr bool PERM = true, AFTER_DRAIN = false;
    bf16_t* O; int ldc;
    __device__ __forceinline__ void operator()(const f32x4 (&acc)[2][2][4][2], const Unit& u, int wr, int wc, int fr, int fq) const {
        const int row0 = u.pm * BM + wr * 64 + fr, col0 = u.pn * BM + wc * 32 + 8 * fq;
#pragma unroll
        for (int ai = 0; ai < 2; ++ai)
#pragma unroll
            for (int m = 0; m < 4; ++m) { const int rr = row0 + ai * HALF + m * 16;
#pragma unroll
                for (int bj = 0; bj < 2; ++bj) { f32x4 v0 = acc[ai][bj][m][0], v1 = acc[ai][bj][m][1];
                    bf16_t* const rowp = O + tl_off(rr, col0, ldc) - bj * HALF + (size_t)bj * 2 * 16384;
#pragma unroll
                    for (int j = 0; j < 4; ++j) { const float a = fmaxf(v0[j], 0.f), b = fmaxf(v1[j], 0.f); v0[j] = a * a; v1[j] = b * b; }
                    u32x4 w; w.x = cvt_pk_bf16(v0[0], v0[1]); w.y = cvt_pk_bf16(v0[2], v0[3]); w.z = cvt_pk_bf16(v1[0], v1[1]); w.w = cvt_pk_bf16(v1[2], v1[3]);
                    *(u32x4*)(rowp + bj * HALF) = w; } }
    }
};

struct EpiRelu2Q {
    static constexpr bool PERM = true, AFTER_DRAIN = false;
    bf16_t* O; int ldc; const PG8_LAS float* scs;
    __device__ __forceinline__ void operator()(const f32x4 (&acc)[2][2][4][2], const Unit& u, int wr, int wc, int fr, int fq) const {
        const int row0 = u.pm * BM + wr * 64 + fr, col0 = u.pn * BM + wc * 32 + 8 * fq; const PG8_LAS float* sa = scs + wr * 64 + fr - row0;
        f32x4 sbv[2][2];
#pragma unroll
        for (int bj = 0; bj < 2; ++bj) { sbv[bj][0] = *(const PG8_LAS f32x4*)(scs + 256 + wc * 32 + 8 * fq + bj * HALF); sbv[bj][1] = *(const PG8_LAS f32x4*)(scs + 256 + wc * 32 + 8 * fq + bj * HALF + 4); }
#pragma unroll
        for (int ai = 0; ai < 2; ++ai)
#pragma unroll
            for (int m = 0; m < 4; ++m) { const int rr = row0 + ai * HALF + m * 16; const float sr = sa[rr];
#pragma unroll
                for (int bj = 0; bj < 2; ++bj) { const v4i32 i0 = __builtin_bit_cast(v4i32, acc[ai][bj][m][0]), i1 = __builtin_bit_cast(v4i32, acc[ai][bj][m][1]);
                    bf16_t* const rowp = O + tl_off(rr, col0, ldc) + (size_t)bj * 2 * 16384;
                    float v[8];
#pragma unroll
                    for (int j = 0; j < 4; ++j) { const float a = fmaxf((float)i0[j] * (sr * sbv[bj][0][j]), 0.f), b = fmaxf((float)i1[j] * (sr * sbv[bj][1][j]), 0.f); v[j] = a * a; v[4 + j] = b * b; }
                    u32x4 w; w.x = cvt_pk_bf16(v[0], v[1]); w.y = cvt_pk_bf16(v[2], v[3]); w.z = cvt_pk_bf16(v[4], v[5]); w.w = cvt_pk_bf16(v[6], v[7]);
                    *(u32x4*)rowp = w; } }
    }
};

typedef int v8i32 __attribute__((ext_vector_type(8)));
template <class Epi, class Sched, bool ALIGN_EPI = false, bool SP2 = false, class Mid = NoMid, int FMT = 0>
__device__ __forceinline__ void gemm_phase(PG8_LAS unsigned char* lds, const Gemm g, const Sched& S, const Epi& E, const Mid& MH = Mid()) {
    constexpr bool FP8 = (FMT == 1), INT8 = (FMT == 2);
    const int tid = threadIdx.x, wid = __builtin_amdgcn_readfirstlane(tid >> 6), lane = tid & 63, wr = wid >> 2, wc = wid & 3, fr = lane & 15, fq = lane >> 4;
    const int K = g.K, nt = K / BK;
    unsigned voffA[2], voffB[2];
#pragma unroll
    for (int i = 0; i < 2; ++i) { int R, C; stage_rc(tid * 16 + i * 8192, R, C); const int Rb = Epi::PERM ? ((R & ~31) + perm32(R & 31)) : R;
        (void)R; (void)C; (void)Rb; voffA[i] = (unsigned)(tid * 16 + i * 8192); voffB[i] = voffA[i]; }
    const size_t kstepA = g.A.kstep, kstepB = g.B.kstep;
    const size_t hstepA = g.A.hstep, hstepB = g.B.hstep;
    const size_t tstepA = g.A.tstep, tstepB = g.B.tstep;
    const unsigned ldsw = (unsigned)wid * 1024u;
    const int aoff = lds_byte(wr * 64 + fr, fq * 8), boff = lds_byte(wc * 32 + fr, fq * 8);
#define PG8_SA(b, h) (((b) * 2 + (h)) * HTB)
#define PG8_SB(b, h) ((4 + (b) * 2 + (h)) * HTB)
#define PG8_STAGE(bufoff, gbase, voff) do { _Pragma("unroll") for (int _i = 0; _i < 2; ++_i) \
        __builtin_amdgcn_global_load_lds((const unsigned*)((const char*)(gbase) + (voff)[_i]), (PG8_LAS unsigned*)(lds + (bufoff) + ldsw + _i * 8192), 16, 0, PG8_AUX); } while (0)
#define PG8_LDA(dst, b, h) do { _Pragma("unroll") for (int m = 0; m < 4; ++m) _Pragma("unroll") for (int k = 0; k < 2; ++k) dst[m][k] = *(const PG8_LAS bf16x8*)(lds + PG8_SA(b, h) + aoff + m * 2048 + k * 1024); } while (0)
#define PG8_LDB(dst, b, h) do { _Pragma("unroll") for (int n = 0; n < 2; ++n) _Pragma("unroll") for (int k = 0; k < 2; ++k) dst[n][k] = *(const PG8_LAS bf16x8*)(lds + PG8_SB(b, h) + boff + n * 2048 + k * 1024); } while (0)
#define PG8_MMA(ai, bj, At, Bt) do { __builtin_amdgcn_s_setprio(1); if constexpr (FP8) { _Pragma("unroll") for (int m = 0; m < 4; ++m) _Pragma("unroll") for (int n = 0; n < 2; ++n) \
        asm volatile("v_mfma_scale_f32_16x16x128_f8f6f4 %0, %1, %2, %0, %3, %4 op_sel_hi:[0,0,0]" : "+v"(acc[ai][bj][m][n]) \
            : "v"(__builtin_bit_cast(v8i32, __builtin_shufflevector(Bt[n][0], Bt[n][1], 0, 1, 2, 3, 4, 5, 6, 7, 8, 9, 10, 11, 12, 13, 14, 15))), \
              "v"(__builtin_bit_cast(v8i32, __builtin_shufflevector(At[m][0], At[m][1], 0, 1, 2, 3, 4, 5, 6, 7, 8, 9, 10, 11, 12, 13, 14, 15))), "v"(0x79797979), "v"(0x7f7f7f7f)); } else if constexpr (INT8) { \
        _Pragma("unroll") for (int m = 0; m < 4; ++m) _Pragma("unroll") for (int n = 0; n < 2; ++n) _Pragma("unroll") for (int k = 0; k < 2; ++k) \
        acc[ai][bj][m][n] = __builtin_bit_cast(f32x4, __builtin_amdgcn_mfma_i32_16x16x64_i8(__builtin_bit_cast(v4i32, Bt[n][k]), __builtin_bit_cast(v4i32, At[m][k]), __builtin_bit_cast(v4i32, acc[ai][bj][m][n]), 0, 0, 0)); } else { \
        _Pragma("unroll") for (int m = 0; m < 4; ++m) _Pragma("unroll") for (int n = 0; n < 2; ++n) _Pragma("unroll") for (int k = 0; k < 2; ++k) \
        acc[ai][bj][m][n] = __builtin_amdgcn_mfma_f32_16x16x32_bf16(Bt[n][k], At[m][k], acc[ai][bj][m][n], 0, 0, 0); } __builtin_amdgcn_s_setprio(0); } while (0)
#define PG8_WAIT_V(n) asm volatile("s_waitcnt vmcnt(" #n ")" ::: "memory")
#define PG8_WAIT_L(n) asm volatile("s_waitcnt lgkmcnt(" #n ")" ::: "memory")
#define PG8_BAR __builtin_amdgcn_s_barrier()
#define PG8_SCHED __builtin_amdgcn_sched_barrier(0)
    Unit cur, nxt; int ui = 0;
    if (!S.next(0, cur)) return;
    f32x4 acc[2][2][4][2];
#pragma unroll
    for (int a = 0; a < 2; ++a)
#pragma unroll
        for (int b = 0; b < 2; ++b)
#pragma unroll
            for (int m = 0; m < 4; ++m)
#pragma unroll
                for (int n = 0; n < 2; ++n) acc[a][b][m][n] = (f32x4){0.f, 0.f, 0.f, 0.f};
    bf16x8 At[4][2], B0[2][2], B1[2][2];
    const char* cA = (const char*)g.A.p + (size_t)cur.pm * tstepA; const char* cB = (const char*)g.B.p + (size_t)cur.pn * tstepB;
    S.a_ready(cur);
    if constexpr (SP2) {
        PG8_STAGE(PG8_SB(0, 0), cB, voffB); PG8_STAGE(PG8_SB(0, 1), cB + hstepB, voffB); PG8_STAGE(PG8_SA(0, 0), cA, voffA); PG8_STAGE(PG8_SA(0, 1), cA + hstepA, voffA);
        if (wr == 1) PG8_BAR;
        PG8_WAIT_V(2); PG8_BAR;
        PG8_STAGE(PG8_SB(1, 0), cB + kstepB, voffB); PG8_STAGE(PG8_SA(1, 0), cA + kstepA, voffA); PG8_STAGE(PG8_SB(1, 1), cB + hstepB + kstepB, voffB);
        PG8_WAIT_V(6); PG8_BAR;
    } else {
        PG8_STAGE(PG8_SB(0, 0), cB, voffB); PG8_STAGE(PG8_SA(0, 0), cA, voffA); PG8_STAGE(PG8_SB(0, 1), cB + hstepB, voffB); PG8_STAGE(PG8_SA(0, 1), cA + hstepA, voffA);
        if (wr == 1) PG8_BAR;
        PG8_WAIT_V(4); PG8_BAR;
        PG8_STAGE(PG8_SB(1, 0), cB + kstepB, voffB); PG8_STAGE(PG8_SA(1, 0), cA + kstepA, voffA); PG8_STAGE(PG8_SB(1, 1), cB + hstepB + kstepB, voffB);
        PG8_WAIT_V(6); PG8_BAR;
    }
    for (;;) {
        const bool has_next = S.next(ui + 1, nxt);
        const char* nA = has_next ? (const char*)g.A.p + (size_t)nxt.pm * tstepA : cA; const char* nB = has_next ? (const char*)g.B.p + (size_t)nxt.pn * tstepB : cB;
        for (int t = 0; t < nt; t += 2) {
            const bool last = (t == nt - 2);
            const char* a1 = cA + (size_t)(t + 1) * kstepA;
            const char* a2 = last ? nA : cA + (size_t)(t + 2) * kstepA; const char* b2 = last ? nB : cB + (size_t)(t + 2) * kstepB;
            const char* a3 = a2 + kstepA; const char* b3 = b2 + kstepB;
            if (last && has_next) S.a_ready(nxt);
            if constexpr (Mid::ACTIVE) { if (t == (nt >> 1)) MH(acc, cur, wr, wc, fr, fq); }
            if constexpr (SP2) {
            PG8_LDB(B0, 0, 0); PG8_LDB(B1, 0, 1); PG8_SCHED; PG8_LDA(At, 0, 0); PG8_STAGE(PG8_SA(1, 1), a1 + hstepA, voffA);
            PG8_WAIT_V(8); PG8_WAIT_L(0); PG8_BAR; PG8_MMA(0, 0, At, B0); PG8_MMA(0, 1, At, B1); PG8_BAR; PG8_SCHED;
            PG8_LDA(At, 0, 1); PG8_STAGE(PG8_SB(0, 0), b2, voffB); PG8_STAGE(PG8_SB(0, 1), b2 + hstepB, voffB); PG8_STAGE(PG8_SA(0, 0), a2, voffA);
            PG8_WAIT_V(8); PG8_WAIT_L(0); PG8_BAR; PG8_MMA(1, 0, At, B0); PG8_MMA(1, 1, At, B1); PG8_BAR; PG8_SCHED;
            PG8_LDB(B0, 1, 0); PG8_LDB(B1, 1, 1); PG8_SCHED; PG8_LDA(At, 1, 0); PG8_STAGE(PG8_SA(0, 1), a2 + hstepA, voffA);
            PG8_WAIT_V(8); PG8_WAIT_L(0); PG8_BAR; PG8_MMA(0, 0, At, B0); PG8_MMA(0, 1, At, B1); PG8_BAR; PG8_SCHED;
            PG8_LDA(At, 1, 1); PG8_STAGE(PG8_SB(1, 0), b3, voffB); PG8_STAGE(PG8_SB(1, 1), b3 + hstepB, voffB); PG8_STAGE(PG8_SA(1, 0), a3, voffA);
            PG8_WAIT_V(8); PG8_WAIT_L(0); PG8_BAR; PG8_MMA(1, 0, At, B0); PG8_MMA(1, 1, At, B1); PG8_BAR; PG8_SCHED;
            } else {
            PG8_LDB(B0, 0, 0); PG8_SCHED; PG8_LDA(At, 0, 0); PG8_STAGE(PG8_SA(1, 1), a1 + hstepA, voffA);
            PG8_WAIT_L(8); PG8_BAR; PG8_WAIT_L(0); PG8_MMA(0, 0, At, B0); PG8_BAR; PG8_SCHED;
            PG8_LDB(B1, 0, 1); PG8_STAGE(PG8_SB(0, 0), b2, voffB);
            PG8_BAR; PG8_WAIT_L(0); PG8_MMA(0, 1, At, B1); PG8_BAR;
            PG8_LDA(At, 0, 1); PG8_STAGE(PG8_SA(0, 0), a2, voffA);
            PG8_BAR; PG8_WAIT_L(0); PG8_MMA(1, 0, At, B0); PG8_BAR; PG8_SCHED;
            PG8_STAGE(PG8_SB(0, 1), b2 + hstepB, voffB);
            PG8_WAIT_V(6); PG8_BAR; PG8_MMA(1, 1, At, B1); PG8_BAR;
            PG8_LDB(B0, 1, 0); PG8_SCHED; PG8_LDA(At, 1, 0); PG8_STAGE(PG8_SA(0, 1), a2 + hstepA, voffA);
            PG8_WAIT_L(8); PG8_BAR; PG8_WAIT_L(0); PG8_MMA(0, 0, At, B0); PG8_BAR; PG8_SCHED;
            PG8_LDB(B1, 1, 1); PG8_STAGE(PG8_SB(1, 0), b3, voffB);
            PG8_BAR; PG8_WAIT_L(0); PG8_MMA(0, 1, At, B1); PG8_BAR;
            PG8_LDA(At, 1, 1); PG8_STAGE(PG8_SA(1, 0), a3, voffA);
            PG8_BAR; PG8_WAIT_L(0); PG8_MMA(1, 0, At, B0); PG8_BAR; PG8_SCHED;
            PG8_STAGE(PG8_SB(1, 1), b3 + hstepB, voffB);
            PG8_WAIT_V(6); PG8_BAR; PG8_MMA(1, 1, At, B1); PG8_BAR;
            }
        }
        if constexpr (ALIGN_EPI) { if (wr == 0) PG8_BAR; }
        if constexpr (FP8) asm volatile("s_nop 15\n\ts_nop 15" ::: "memory");
        E(acc, cur, wr, wc, fr, fq); S.done(cur);
        if (!has_next) break;
#pragma unroll
        for (int a = 0; a < 2; ++a)
#pragma unroll
            for (int b = 0; b < 2; ++b)
#pragma unroll
                for (int m = 0; m < 4; ++m)
#pragma unroll
                    for (int n = 0; n < 2; ++n) acc[a][b][m][n] = (f32x4){0.f, 0.f, 0.f, 0.f};
        cur = nxt; cA = nA; cB = nB; ++ui;
        if constexpr (ALIGN_EPI) { if (wr == 1) PG8_BAR; }
    }
    PG8_WAIT_V(0);
    if constexpr (!ALIGN_EPI) { if (wr == 0) PG8_BAR; }
    PG8_BAR;
#undef PG8_SA
#undef PG8_SB
#undef PG8_STAGE
#undef PG8_LDA
#undef PG8_LDB
#undef PG8_MMA
#undef PG8_WAIT_V
#undef PG8_WAIT_L
#undef PG8_BAR
#undef PG8_SCHED
}
}

#ifndef PG8_SP2
#define PG8_SP2 true
#endif
#ifndef PG8_ALIGN
#define PG8_ALIGN true
#endif

constexpr int NWAVES = 8;
constexpr int D = 4096, NB = 4, T = 4096, M = NB * T, CTXL = 256, MC = NB * CTXL, MALL = M + MC;
constexpr int AW = 2048, NH = 16, HK = 128, HV = 128, BW = 2048, NG = 16, GC = 128, MIXC = 128, DFF = 16384, NIN = 22528, NMOD = 6;
constexpr float LN_EPS = 1e-6f;
constexpr float ALPHA = 1.189207115002721f;

constexpr size_t MiB = 1u << 20;
constexpr size_t WS_CTL = 0, CTL_ZERO_BYTES = 1 * MiB;
constexpr size_t WS_ETAB = 1 * MiB;
constexpr size_t WS_MODX = 1 * MiB + 512 * 1024;
constexpr size_t WS_MODC = WS_MODX + 4 * 24576 * 4;
constexpr size_t WS_STAT = 2 * MiB;
constexpr size_t WS_ST1 = 2 * MiB + 256 * 1024;
constexpr size_t WS_SA2 = 2 * MiB + 384 * 1024;
constexpr size_t WS_SB1 = 2 * MiB + 448 * 1024;
constexpr size_t WS_LB = 2 * MiB + 512 * 1024;
constexpr size_t WS_SA1 = 2 * MiB + 576 * 1024;
constexpr size_t WS_SB0 = 2 * MiB + 768 * 1024;
constexpr size_t WS_DSUM = 3 * MiB;
constexpr size_t WS_WPAB = 8 * MiB;
constexpr size_t WS_WOUT = 40 * MiB;
constexpr size_t WS_WFF1 = 72 * MiB;
constexpr size_t WS_WFF2 = 200 * MiB;
constexpr size_t WS_OBUF = WS_WFF1;
constexpr size_t WS_WIN = 328 * MiB;
constexpr size_t WS_WIN8 = WS_WIN;
constexpr size_t WS_WINB = WS_WIN + 96 * MiB;
constexpr size_t WS_H8 = 1360 * MiB;
constexpr size_t WS_HBUF = 504 * MiB;
constexpr size_t WS_P = 640 * MiB;
constexpr size_t WS_ABUF = 640 * MiB;
constexpr size_t WS_Y = 1360 * MiB;
constexpr size_t WS_END = 1488 * MiB;
constexpr size_t WS_LBUF = WS_WIN;
static_assert(WS_LBUF + (size_t)8704 * 16384 * 2 <= WS_P, "L region");
static_assert(WS_P + (4 * pg8::SZ4 + 3 * pg8::SZ3 + 2 * pg8::SZG) * 2 <= WS_Y, "p region");
static_assert(WS_HBUF + (size_t)MALL * D * 2 <= WS_P && WS_WIN + (size_t)NIN * D * 2 <= WS_HBUF, "ws map");
constexpr int CW_TMO = 0, CW_BAR = 4096;

constexpr int RING_OFF = 0, RING_BYTES = 131072;
constexpr int LDSCTL_OFF = RING_BYTES, MISC_OFF = LDSCTL_OFF + 320;
constexpr int LDS_BYTES = 147456;

#define GAS __attribute__((address_space(1)))
#define LAS __attribute__((address_space(3)))
typedef unsigned short bf16;
typedef unsigned v4u __attribute__((ext_vector_type(4)));
typedef unsigned v2u __attribute__((ext_vector_type(2)));
typedef float f32x4 __attribute__((ext_vector_type(4)));
typedef GAS unsigned gu32;
#define RLX_AGENT __ATOMIC_RELAXED, __HIP_MEMORY_SCOPE_AGENT
#define LDS_WAIT() asm volatile("s_waitcnt lgkmcnt(0)" ::: "memory")
#define VM_WAIT() asm volatile("s_waitcnt vmcnt(0)" ::: "memory")
__device__ __forceinline__ unsigned f2bf(float f) { unsigned u = __builtin_bit_cast(unsigned, f); return (u + 0x7fffu + ((u >> 16) & 1u)) >> 16; }
typedef float f32x2v_ __attribute__((ext_vector_type(2)));
typedef __bf16 bf16x2v_ __attribute__((ext_vector_type(2)));
__device__ __forceinline__ unsigned pk2(float lo, float hi) { const f32x2v_ v = {lo, hi}; return __builtin_bit_cast(unsigned, __builtin_convertvector(v, bf16x2v_)); }
__device__ __forceinline__ float bf2f(bf16 b) { return __uint_as_float(((unsigned)b) << 16); }
__device__ __forceinline__ int opq(int x) { asm volatile("" : "+v"(x)); return x; }
__device__ __forceinline__ unsigned pack_i8(float a, float b, float c, float d) {
    const int ia = (int)__builtin_rintf(a), ib = (int)__builtin_rintf(b), ic = (int)__builtin_rintf(c), id = (int)__builtin_rintf(d);
    return (unsigned)(ia & 255) | ((unsigned)(ib & 255) << 8) | ((unsigned)(ic & 255) << 16) | ((unsigned)id << 24); }

using pg8::bflo; using pg8::bfhi; using pg8::sigm;

#define XB_TMO      128
#define XB_XCNT(j)  (256  + 64 * (j))
#define XB_XSUB(j)  (1280 + 64 * (j))
#define XB_XGEN(j)  (2304 + 64 * (j))
#define XB_TOP      3328
#define XB_TOPGEN   3392
#define XCD_BAR_WORDS 3456
#define XB_SPIN_CAP (1u << 22)

__device__ __forceinline__ unsigned xb_ld(unsigned* p)              { return __hip_atomic_load(p, __ATOMIC_RELAXED, __HIP_MEMORY_SCOPE_AGENT); }
__device__ __forceinline__ unsigned xb_add(unsigned* p, unsigned v) { return __hip_atomic_fetch_add(p, v, __ATOMIC_RELAXED, __HIP_MEMORY_SCOPE_AGENT); }
__device__ __forceinline__ unsigned xb_xcc_id() { return (unsigned)__builtin_amdgcn_s_getreg((3 << 11) | 20) & 0xFu; }
#define XB_SPIN(cond, bar) do { unsigned _sp = 0; while (cond) { __builtin_amdgcn_s_sleep(1); \
    if ((++_sp & 255u) == 0u) { if (xb_ld(&(bar)[XB_TMO])) break; if (_sp > XB_SPIN_CAP) { atomicAdd(&(bar)[XB_TMO], 1u); break; } } } } while (0)

struct XcdBarrier { unsigned* bar; unsigned x; volatile LAS unsigned* st; };
__device__ __forceinline__ XcdBarrier xcd_barrier_post(unsigned* bar, volatile LAS unsigned* st) {
    XcdBarrier b; b.bar = bar; b.x = xb_xcc_id(); b.st = st;
    if (threadIdx.x == 0) (void)xb_add(&bar[XB_XCNT(b.x)], 1u);
    return b;
}
__device__ __forceinline__ void xcd_barrier_complete(unsigned* bar, unsigned x, unsigned& nloc, unsigned& nx) {
    const unsigned G = gridDim.x * gridDim.y * gridDim.z;
    unsigned sum, cnt, mine, sp = 0u;
    for (;;) {
        sum = 0u; cnt = 0u; mine = 0u;
#pragma unroll
        for (unsigned j = 0; j < 16; ++j) { const unsigned c = xb_ld(&bar[XB_XCNT(j)]); sum += c; cnt += (c > 0u) ? 1u : 0u; mine = (j == x) ? c : mine; }
        if (sum == G) break;
        __builtin_amdgcn_s_sleep(1);
        if ((++sp & 255u) == 0u) { if (xb_ld(&bar[XB_TMO])) break; if (sp > XB_SPIN_CAP) { atomicAdd(&bar[XB_TMO], 1u); break; } }
    }
    nloc = mine > 0u ? mine : 1u; nx = cnt > 0u ? cnt : 1u;
}
__device__ __forceinline__ void xcd_barrier(const XcdBarrier& b) {
    asm volatile("s_waitcnt vmcnt(0)" ::: "memory");
    __syncthreads();
    if (threadIdx.x == 0) {
        unsigned* bar = b.bar;
        __builtin_amdgcn_s_waitcnt(0);
        unsigned nloc = b.st[0], nx = b.st[1];
        if (nloc == 0u) { xcd_barrier_complete(bar, b.x, nloc, nx); b.st[0] = nloc; b.st[1] = nx; }
        const unsigned old = xb_add(&bar[XB_XSUB(b.x)], 1u);
        const unsigned gen = old / nloc;
        if (old + 1u == (gen + 1u) * nloc) {
            __builtin_amdgcn_fence(__ATOMIC_RELEASE, "agent");
            asm volatile("s_waitcnt vmcnt(0)" ::: "memory");
            const unsigned og = xb_add(&bar[XB_TOP], 1u);
            const unsigned tg = og / nx;
            if (og + 1u == (tg + 1u) * nx) xb_add(&bar[XB_TOPGEN], 1u);
            else XB_SPIN(xb_ld(&bar[XB_TOPGEN]) == tg, bar);
            __builtin_amdgcn_fence(__ATOMIC_ACQUIRE, "agent");
            xb_add(&bar[XB_XGEN(b.x)], 1u);
            asm volatile("s_waitcnt vmcnt(0)" ::: "memory");
        } else {
            XB_SPIN(xb_ld(&bar[XB_XGEN(b.x)]) == gen, bar);
            __builtin_amdgcn_fence(__ATOMIC_ACQUIRE, "agent");
            asm volatile("s_waitcnt vmcnt(0)" ::: "memory");
        }
    }
    __syncthreads();
}

struct Frame {
    LAS unsigned char* lds;
    volatile LAS unsigned* MISC;
    gu32* ctl;
    int tid, lane, wave, G;
    const float *x, *c, *ctx, *c_ctx, *w_ada, *b_ada, *w_in, *lbl, *a_norm_g, *w_proj_a, *v_norm_g, *v_norm_b, *w_s, *b_s, *w_proj_b, *w_out, *ln1_g, *ln1_b, *w_ff1, *w_ff2, *ln2_g, *ln2_b;
    float* out; unsigned char* ws;
};
template <int CTRL> __device__ __forceinline__ float dpp_perm(float x) { return __builtin_bit_cast(float, __builtin_amdgcn_update_dpp(0, __builtin_bit_cast(int, x), CTRL, 0xf, 0xf, true)); }
__device__ __forceinline__ float lane_val(float v, int l) { return __builtin_bit_cast(float, __builtin_amdgcn_readlane(__builtin_bit_cast(int, v), l)); }
__device__ __forceinline__ float wave_sum(float v) {
    v += dpp_perm<0xB1>(v); v += dpp_perm<0x4E>(v); v += dpp_perm<0x141>(v); v += dpp_perm<0x140>(v);
    return (lane_val(v, 0) + lane_val(v, 16)) + (lane_val(v, 32) + lane_val(v, 48));
}
__device__ __forceinline__ float wave_max(float v) {
    v = fmaxf(v, dpp_perm<0xB1>(v)); v = fmaxf(v, dpp_perm<0x4E>(v)); v = fmaxf(v, dpp_perm<0x141>(v)); v = fmaxf(v, dpp_perm<0x140>(v));
    return fmaxf(fmaxf(lane_val(v, 0), lane_val(v, 16)), fmaxf(lane_val(v, 32), lane_val(v, 48)));
}

__device__ __forceinline__ float lb_of(const float* lbl, int dir, int ch) { const float l0 = lbl[dir * 4096 + ch], l1 = lbl[dir * 4096 + 2048 + ch]; return 1.0f / (1.0f + expf(l1 - l0)); }
__device__ __forceinline__ void p0_transpose_item(const float* W, int N, bf16* WT, int ldk, int kofs, bool perm, LAS float* scr, int item, int lane) {
    const int nblk = N / 32, kb = item / nblk, nb = item % nblk, k0 = 64 * kb, n0 = 32 * nb;
    { float t[32]; const float* wp = W + (size_t)(k0 + (lane >> 5)) * N + n0 + (lane & 31);
#pragma unroll
      for (int i = 0; i < 32; ++i) t[i] = wp[(size_t)(2 * i) * N];
      LAS float* sw = scr + (lane >> 5) * 33 + (lane & 31);
#pragma unroll
      for (int i = 0; i < 32; ++i) sw[2 * i * 33] = t[i]; }
    LDS_WAIT(); asm volatile("" ::: "memory");
    const int c = lane & 7;
#pragma unroll
    for (int j = 0; j < 4; ++j) { const int n = (lane >> 3) + 8 * j; const LAS float* s = scr + (8 * c) * 33 + n;
        v4u o; o.x = pk2(s[0 * 33], s[1 * 33]); o.y = pk2(s[2 * 33], s[3 * 33]); o.z = pk2(s[4 * 33], s[5 * 33]); o.w = pk2(s[6 * 33], s[7 * 33]);
        *(GAS v4u*)(WT + pg8::tl_off_b(n0 + n, kofs + k0 + 8 * c, ldk, perm)) = o; }
    LDS_WAIT(); asm volatile("" ::: "memory");
}

__device__ __forceinline__ void p0_mod_unit(Frame& F, int unit) {
    LAS float* sl = (LAS float*)(F.lds + RING_OFF);
    LAS float* red = (LAS float*)(F.lds + RING_OFF + 5 * 4096 * 4);
    for (int i = F.tid; i < 5 * 4096; i += NWAVES * 64) { const int r = i >> 12, k = i & 4095; const float v = (r < 4) ? F.c[r * 4096 + k] : F.c_ctx[k]; sl[i] = v * sigm(v); }
    __syncthreads();
    const int col = 128 * unit + 4 * (F.lane & 31), rg = F.wave * 2 + (F.lane >> 5);
    f32x4 a0 = {0.f, 0.f, 0.f, 0.f}, a1 = a0, a2 = a0, a3 = a0, a4 = a0;
    const float* wp = F.w_ada + (size_t)rg * 24576 + col;
    for (int i0 = 0; i0 < 256; i0 += 32) {
        f32x4 wv[32];
#pragma unroll
        for (int i = 0; i < 32; ++i) wv[i] = *(const GAS f32x4*)(wp + (size_t)(i0 + i) * 16 * 24576);
#pragma unroll
        for (int i = 0; i < 32; ++i) { const int k = rg + 16 * (i0 + i); const f32x4 w = wv[i];
            a0 += w * sl[k]; a1 += w * sl[4096 + k]; a2 += w * sl[8192 + k]; a3 += w * sl[12288 + k]; a4 += w * sl[16384 + k]; } }
    LAS f32x4* r4 = (LAS f32x4*)red + (rg * 5) * 32 + (F.lane & 31);
    r4[0] = a0; r4[32] = a1; r4[64] = a2; r4[96] = a3; r4[128] = a4;
    __syncthreads();
    for (int i = F.tid; i < 5 * 128; i += NWAVES * 64) { const int r = i >> 7, cc = i & 127; float s = 0.f;
#pragma unroll
        for (int g = 0; g < 16; ++g) s += red[(g * 5 + r) * 128 + cc];
        const int gc = 128 * unit + cc; s += F.b_ada[gc];
        if (r < 4) ((float*)(F.ws + WS_MODX))[r * 24576 + gc] = s; else ((float*)(F.ws + WS_MODC))[gc] = s; }
    __syncthreads();
}

template <class NSrc> __device__ __forceinline__ void quant_cols(Frame& F, const float* W, int N, int nblocks, unsigned char* W8, float* sb, NSrc nsrc) {
    LAS float* scr = (LAS float*)(F.lds + RING_OFF + F.wave * 16384);
    LAS float* cmax = (LAS float*)(F.lds + RING_OFF + 8 * 16384 - 2048);
    LAS float* cinv = cmax + 256;
    const int kq = F.wave, lane = F.lane;
    for (int pb = blockIdx.x; pb < nblocks; pb += F.G) {
        const int n8 = pb * 32, n0 = nsrc(n8);
        float amax = 0.f;
        for (int kb = kq * 8; kb < kq * 8 + 8; kb += 2) { const int ln = opq(lane); const float* wp = W + (size_t)(64 * kb + (ln >> 5)) * N + n0 + (ln & 31);
            float t[64];
#pragma unroll
            for (int i = 0; i < 64; ++i) t[i] = wp[(size_t)(2 * i) * N];
#pragma unroll
            for (int i = 0; i < 64; ++i) amax = fmaxf(amax, fabsf(t[i])); }
        amax = fmaxf(amax, __shfl_xor(amax, 32));
        if (lane < 32) cmax[kq * 32 + lane] = amax;
        __syncthreads();
        if (kq == 0 && lane < 32) { float mx = 1e-30f;
#pragma unroll
            for (int q = 0; q < 8; ++q) mx = fmaxf(mx, cmax[q * 32 + lane]);
            cinv[lane] = 127.0f / mx; sb[n8 + lane] = mx * (1.0f / 127.0f); }
        __syncthreads();
        for (int kb = kq * 8; kb < kq * 8 + 8; ++kb) { const int k0 = 64 * kb; const int ln = opq(lane);
            const float* wp = W + (size_t)(k0 + (ln >> 5)) * N + n0 + (ln & 31); LAS float* sw = scr + (ln >> 5) * 33 + (ln & 31);
            { float t[32];
#pragma unroll
              for (int i = 0; i < 32; ++i) t[i] = wp[(size_t)(2 * i) * N];
#pragma unroll
              for (int i = 0; i < 32; ++i) sw[2 * i * 33] = t[i]; }
            LDS_WAIT(); asm volatile("" ::: "memory");
            const int c = ln & 7;
#pragma unroll
            for (int j = 0; j < 4; ++j) { const int n = (ln >> 3) + 8 * j; const LAS float* sp = scr + (8 * c) * 33 + n; const float iv = cinv[n];
                v2u o; o.x = pack_i8(sp[0 * 33] * iv, sp[1 * 33] * iv, sp[2 * 33] * iv, sp[3 * 33] * iv); o.y = pack_i8(sp[4 * 33] * iv, sp[5 * 33] * iv, sp[6 * 33] * iv, sp[7 * 33] * iv);
                *(GAS v2u*)(W8 + pg8::tl_off_b(n8 + n, (k0 + 8 * c) >> 1, 2048, true) * 2) = o; }
            LDS_WAIT(); asm volatile("" ::: "memory"); }
        __syncthreads();
    }
}
struct NSrcId { __device__ __forceinline__ int operator()(int n8) const { return n8; } };
struct NSrcIn { __device__ __forceinline__ int operator()(int n8) const { return n8 < 8192 ? n8 : (n8 < 16384 ? n8 + 6144 : (n8 < 18432 ? n8 - 8192 : (n8 < 20480 ? n8 - 6144 : n8 - 10240))); } };
__device__ __forceinline__ void p0_transpose_item8(const float* W, int N, unsigned char* W8, int n_src0, int n8_0, LAS float* scr, int kb, int lane) {
    const int k0 = 64 * kb;
#pragma unroll 8
    for (int i = 0; i < 32; ++i) { const int kk = 2 * i + (lane >> 5); scr[kk * 33 + (lane & 31)] = W[(size_t)(k0 + kk) * N + n_src0 + (lane & 31)]; }
    LDS_WAIT(); asm volatile("" ::: "memory");
    const int c = lane & 7;
#pragma unroll
    for (int j = 0; j < 4; ++j) { const int n = (lane >> 3) + 8 * j; const LAS float* sp = scr + (8 * c) * 33 + n;
        unsigned lo = 0u, hi = 0u;
        lo = __builtin_amdgcn_cvt_pk_fp8_f32(sp[0 * 33] * 64.f, sp[1 * 33] * 64.f, lo, false); lo = __builtin_amdgcn_cvt_pk_fp8_f32(sp[2 * 33] * 64.f, sp[3 * 33] * 64.f, lo, true);
        hi = __builtin_amdgcn_cvt_pk_fp8_f32(sp[4 * 33] * 64.f, sp[5 * 33] * 64.f, hi, false); hi = __builtin_amdgcn_cvt_pk_fp8_f32(sp[6 * 33] * 64.f, sp[7 * 33] * 64.f, hi, true);
        v2u o; o.x = lo; o.y = hi;
        *(GAS v2u*)(W8 + pg8::tl_off_b(n8_0 + n, (k0 + 8 * c) >> 1, 2048, true) * 2) = o; }
    LDS_WAIT(); asm volatile("" ::: "memory");
}
__device__ __forceinline__ void p0_prologue(Frame& F) {
    if ((int)blockIdx.x < 64) { const int p = blockIdx.x; float* E = (float*)(F.ws + WS_ETAB) + p * 2048;
        for (int i = F.tid; i < 1024; i += NWAVES * 64) { const float om = 1.0f / powf(10000.0f, (float)i * (1.0f / 1024.0f)); const float a = (float)p * om; E[i] = sinf(a); E[1024 + i] = cosf(a); } }
    if ((int)blockIdx.x == 64 % F.G) { float* LB = (float*)(F.ws + WS_LB); for (int i = F.tid; i < 4096; i += NWAVES * 64) LB[i] = lb_of(F.lbl, i >> 11, i & 2047); }
    for (int u = blockIdx.x; u < 192; u += F.G) p0_mod_unit(F, u);
    __syncthreads();
    LAS float* scr = (LAS float*)(F.lds + RING_OFF + F.wave * 16384);
    const int gw = blockIdx.x * NWAVES + F.wave, NGW = F.G * NWAVES;
    quant_cols(F, F.w_in, NIN, (16384 + I8_GV * 4096 + I8_U * 2048) / 32, (unsigned char*)(F.ws + WS_WIN8), (float*)(F.ws + WS_SB0), NSrcIn());
    constexpr int NBLO = I8_GV ? 64 : 0, NB16 = I8_U ? 0 : (I8_GV ? 64 : 192), I_BF = (D / 64) * NB16, I_IN = I_BF, I_PA = (AW / 64) * (D / 32), I_PB = I_PA, I_OUT = (D / 64) * (D / 32);
    constexpr int NITEMS = I_IN + I_PA + I_PB + I_OUT;
    for (int it = gw; it < NITEMS; it += NGW) {
        int r = it;
        if (NB16 > 0 && r < I_BF) { const int kb = r / (NB16 > 0 ? NB16 : 1), nb = 256 + NBLO + r % (NB16 > 0 ? NB16 : 1);
            p0_transpose_item(F.w_in, NIN, (bf16*)(F.ws + WS_WINB) - (size_t)32 * 64 * 16384, D, 0, true, scr, kb * (NIN / 32) + nb, F.lane); continue; }
        r -= I_IN;
        if (r < I_PA) { p0_transpose_item(F.w_proj_a, D, (bf16*)(F.ws + WS_WPAB), D, 0, true, scr, r, F.lane); continue; } r -= I_PA;
        if (r < I_PB) { p0_transpose_item(F.w_proj_b, D, (bf16*)(F.ws + WS_WPAB), D, 2048, true, scr, r, F.lane); continue; } r -= I_PB;
        p0_transpose_item(F.w_out, D, (bf16*)(F.ws + WS_WOUT), D, 0, false, scr, r, F.lane);
    }
}
__device__ __forceinline__ void ff_weight_copies(Frame& F) {
    quant_cols(F, F.w_ff1, DFF, DFF / 32, (unsigned char*)(F.ws + WS_WFF1), (float*)(F.ws + WS_SB1), NSrcId());
    LAS float* scr = (LAS float*)(F.lds + RING_OFF + F.wave * 16384);
    const int gw = blockIdx.x * NWAVES + F.wave, NGW = F.G * NWAVES;
    constexpr int I_2 = (DFF / 64) * (D / 32);
    for (int it = gw; it < I_2; it += NGW) p0_transpose_item(F.w_ff2, D, (bf16*)(F.ws + WS_WFF2), DFF, 0, false, scr, it, F.lane);
}

__device__ __forceinline__ const float* opqp(const float* p) { asm volatile("" : "+s"(p)); return p; }
__device__ __forceinline__ void ld_row16(const float* p, int lane, f32x4 (&v)[16]) {
    const GAS f32x4* xr = (const GAS f32x4*)p + lane;
#pragma unroll
    for (int j = 0; j < 16; ++j) v[j] = xr[64 * j];
}
__device__ __forceinline__ float ln_center(f32x4 (&v)[16]) {
    float s = 0.f;
#pragma unroll
    for (int j = 0; j < 16; ++j) s += (v[j].x + v[j].y) + (v[j].z + v[j].w);
    const float mean = wave_sum(s) * (1.f / D); float s2 = 0.f;
#pragma unroll
    for (int j = 0; j < 16; ++j) { v[j] = v[j] - mean; s2 += (v[j].x * v[j].x + v[j].y * v[j].y) + (v[j].z * v[j].z + v[j].w * v[j].w); }
    return 1.f / sqrtf(wave_sum(s2) * (1.f / D) + LN_EPS);
}
__device__ __forceinline__ void adaln_store(int lane, int m, f32x4 (&v)[16], float rstd, const float* shift, const float* scale, bf16* hb, unsigned char* h8 = nullptr, float* sa = nullptr) {
    const GAS f32x4* sh = (const GAS f32x4*)opqp(shift) + lane; const GAS f32x4* sc = (const GAS f32x4*)opqp(scale) + lane;
    bf16* const ob = hb + pg8::tl_off(m, 4 * lane, D);
    float amax = 0.f;
#pragma unroll
    for (int j = 0; j < 16; ++j) { const f32x4 a = sh[64 * j], b = sc[64 * j]; const f32x4 y = v[j] * rstd * (b + 1.0f) + a; if (hb) { v2u w; w.x = pk2(y.x, y.y); w.y = pk2(y.z, y.w); *(GAS v2u*)(ob + (size_t)j * 4 * 16384) = w; }
        v[j] = y; amax = fmaxf(amax, fmaxf(fmaxf(fabsf(y.x), fabsf(y.y)), fmaxf(fabsf(y.z), fabsf(y.w))));
        if ((j & 3) == 3) asm volatile("" ::: "memory"); }
    if (h8) {
        amax = wave_max(amax);
        amax = fmaxf(amax, 1e-20f);
        if (lane == 0) sa[m] = amax * (1.0f / 127.0f);
        const float inv = 127.0f / amax;
        unsigned char* const o8 = h8 + pg8::tl_off(m, 2 * lane, 2048) * 2;
#pragma unroll
        for (int j = 0; j < 16; ++j) *(GAS unsigned*)(o8 + (size_t)j * 2 * 16384 * 2) = pack_i8(v[j].x * inv, v[j].y * inv, v[j].z * inv, v[j].w * inv); }
}
__device__ __forceinline__ const float* p1_src(Frame& F, int m) { return m < M ? F.x + (size_t)m * D : F.ctx + (size_t)(m - M) * D; }
__device__ __forceinline__ void p1_process(Frame& F, int lane, int m, f32x4 (&v)[16]) {
    const bool isx = m < M;
    const float* mod = isx ? (const float*)(F.ws + WS_MODX) + (size_t)(m >> 12) * 24576 : (const float*)(F.ws + WS_MODC);
    if (isx) { const float* E = (const float*)(F.ws + WS_ETAB); const int t = m & 4095, pr = t >> 6, pc = t & 63;
        const GAS f32x4* e0 = (const GAS f32x4*)(E + pr * 2048) + lane; const GAS f32x4* e1 = (const GAS f32x4*)(E + pc * 2048) + lane;
#pragma unroll
        for (int j = 0; j < 8; ++j) { v[j] += e0[64 * j]; v[8 + j] += e1[64 * j]; } }
    const float rstd = ln_center(v);
    adaln_store(lane, m, v, rstd, mod, mod + 4096, I8_U ? (bf16*)nullptr : (bf16*)(F.ws + WS_HBUF), (unsigned char*)(F.ws + WS_H8), (float*)(F.ws + WS_SA1));
}
__device__ __forceinline__ void adaln_store_l(int lane, int m, f32x4 (&v)[16], float rstd, const LAS f32x4* shl, const LAS f32x4* scl, unsigned char* h8, float* sa) {
    float amax = 0.f;
#pragma unroll
    for (int j = 0; j < 16; ++j) { const f32x4 a = shl[64 * j], b = scl[64 * j]; const f32x4 y = v[j] * rstd * (b + 1.0f) + a;
        v[j] = y; amax = fmaxf(amax, fmaxf(fmaxf(fabsf(y.x), fabsf(y.y)), fmaxf(fabsf(y.z), fabsf(y.w)))); }
    amax = wave_max(amax);
    amax = fmaxf(amax, 1e-20f);
    if (lane == 0) sa[m] = amax * (1.0f / 127.0f);
    const float inv = 127.0f / amax;
    unsigned char* const o8 = h8 + pg8::tl_off(m, 2 * lane, 2048) * 2;
#pragma unroll
    for (int j = 0; j < 16; ++j) *(GAS unsigned*)(o8 + (size_t)j * 2 * 16384 * 2) = pack_i8(v[j].x * inv, v[j].y * inv, v[j].z * inv, v[j].w * inv);
}
__device__ __forceinline__ void p1_addE(Frame& F, int lane, int m, f32x4 (&v)[16]) {
    if (m < M) { const float* E = (const float*)(F.ws + WS_ETAB); const int t = m & 4095, pr = t >> 6, pc = t & 63;
        const GAS f32x4* e0 = (const GAS f32x4*)(E + pr * 2048) + lane; const GAS f32x4* e1 = (const GAS f32x4*)(E + pc * 2048) + lane;
        f32x4 e[16];
#pragma unroll
        for (int j = 0; j < 8; ++j) { e[j] = e0[64 * j]; e[8 + j] = e1[64 * j]; }
        asm volatile("" : "+v"(e[0]), "+v"(e[1]), "+v"(e[2]), "+v"(e[3]), "+v"(e[4]), "+v"(e[5]), "+v"(e[6]), "+v"(e[7]), "+v"(e[8]), "+v"(e[9]), "+v"(e[10]), "+v"(e[11]), "+v"(e[12]), "+v"(e[13]), "+v"(e[14]), "+v"(e[15]));
#pragma unroll
        for (int j = 0; j < 16; ++j) v[j] += e[j]; }
}
__device__ __forceinline__ void p1_finish(Frame& F, int lane_, int m, f32x4 (&v)[16], const LAS float* SHb) {
    const int lane = opq(lane_); const LAS f32x4* shl = (const LAS f32x4*)SHb + lane; const LAS f32x4* scl = shl + 1024;
    const float rstd = ln_center(v);
    adaln_store_l(lane, m, v, rstd, shl, scl, (unsigned char*)(F.ws + WS_H8), (float*)(F.ws + WS_SA1));
}
__device__ __forceinline__ void p1_rows(Frame& F) {
    const int gw = blockIdx.x * NWAVES + F.wave, NGW = F.G * NWAVES;
    LAS float* SH = (LAS float*)(F.lds + RING_OFF);
    f32x4 a[16], b[16]; const int lane = opq(F.tid & 63);
    for (int seg = 0; seg < 5; ++seg) {
        const int base = seg < 4 ? seg * 4096 : M, nrows = seg < 4 ? 4096 : MC;
        const float* mod = seg < 4 ? (const float*)(F.ws + WS_MODX) + (size_t)seg * 24576 : (const float*)(F.ws + WS_MODC);
        const int r0 = gw;
        if (r0 < nrows) ld_row16(p1_src(F, base + r0), lane, a);
        for (int i = F.tid; i < 2048; i += NWAVES * 64) ((LAS f32x4*)SH)[i] = ((const GAS f32x4*)mod)[i];
        __syncthreads();
        for (int r = r0; r < nrows; r += 2 * NGW) { const int r1 = r + NGW, r2 = r + 2 * NGW;
            p1_addE(F, lane, base + r, a);
            if (r1 < nrows) ld_row16(p1_src(F, base + r1), lane, b);
            p1_finish(F, lane, base + r, a, SH);
            if (r1 < nrows) { p1_addE(F, lane, base + r1, b); if (r2 < nrows) ld_row16(p1_src(F, base + r2), lane, a); p1_finish(F, lane, base + r1, b, SH); } }
        __syncthreads();
    }
}

__device__ __forceinline__ void scan_naive_unit(Frame& F, int unit) {
    const int dir = unit & 1, vh = (unit >> 1) & 1, h = (unit >> 2) & 15, b = unit >> 6;
    LAS float* fq = (LAS float*)(F.lds + RING_OFF);
    LAS float* kq = fq + 32 * 128; LAS float* qq = kq + 32 * 128;
    LAS float* vv = qq + 32 * 128;
    LAS float* red = vv + 32 * 64;
    const bf16* P = (const bf16*)(F.ws + WS_P);
    const bf16* qh = P; const bf16* vi = P + pg8::SZ4; const bf16* zz = P + (size_t)(2 + dir) * pg8::SZ4;
    float* obuf = (float*)(F.ws + WS_OBUF) + (size_t)dir * M * AW;
    float S[16];
#pragma unroll
    for (int i = 0; i < 16; ++i) S[i] = 0.f;
    for (int n0 = 0; n0 < CTXL + T; n0 += 32) {
#pragma unroll
        for (int j = 0; j < 8; ++j) { const int idx = F.tid + 512 * j, tok = idx >> 7, k = idx & 127, n = n0 + tok;
            const int row = (n < CTXL) ? (M + b * CTXL + (dir ? CTXL - 1 - n : n)) : (b * T + (dir ? T - 1 - (n - CTXL) : (n - CTXL)));
            const int ch = h * 128 + k; const float z = bf2f(zz[(size_t)row * AW + ch]); const float lb = lb_of(F.lbl, dir, ch);
            const float sg = 1.0f / (1.0f + expf(-z));
            fq[idx] = lb + (1.0f - lb) * sg; kq[idx] = (1.0f - lb) * (1.0f - sg); qq[idx] = bf2f(qh[(size_t)row * AW + ch]); }
#pragma unroll
        for (int j = 0; j < 4; ++j) { const int idx = F.tid + 512 * j, tok = idx >> 6, v = idx & 63, n = n0 + tok;
            const int row = (n < CTXL) ? (M + b * CTXL + (dir ? CTXL - 1 - n : n)) : (b * T + (dir ? T - 1 - (n - CTXL) : (n - CTXL)));
            vv[idx] = bf2f(vi[(size_t)row * AW + h * 128 + vh * 64 + v]); }
        __syncthreads();
        for (int tok = 0; tok < 32; ++tok) { const float vval = vv[tok * 64 + F.lane]; float part = 0.f;
#pragma unroll
            for (int kk = 0; kk < 16; ++kk) { const int o = tok * 128 + F.wave * 16 + kk; S[kk] = fq[o] * S[kk] + kq[o] * vval; part += S[kk] * qq[o]; }
            red[(tok * 8 + F.wave) * 64 + F.lane] = part; }
        __syncthreads();
        if (n0 >= CTXL) {
#pragma unroll
            for (int j = 0; j < 4; ++j) { const int idx = F.tid + 512 * j, tok = idx >> 6, v = idx & 63, n = n0 + tok; float s = 0.f;
#pragma unroll
                for (int w = 0; w < 8; ++w) s += red[(tok * 8 + w) * 64 + v];
                const int row = b * T + (dir ? T - 1 - (n - CTXL) : (n - CTXL));
                obuf[(size_t)row * AW + h * 128 + vh * 64 + v] = s; } }
        __syncthreads();
    }
}
__device__ __forceinline__ void vb_stats_rows(Frame& F) {
    const int gw = blockIdx.x * NWAVES + F.wave, NGW = F.G * NWAVES;
    const bf16* vB = (const bf16*)(F.ws + WS_P) + 4 * pg8::SZ4 + 2 * pg8::SZ3;
    for (int m = gw; m < M; m += NGW) {
        const GAS v4u* r = (const GAS v4u*)(vB + (size_t)m * BW) + F.lane;
        float v[32]; float s = 0.f;
#pragma unroll
        for (int j = 0; j < 4; ++j) { const v4u w = r[64 * j]; v[8 * j] = bflo(w.x); v[8 * j + 1] = bfhi(w.x); v[8 * j + 2] = bflo(w.y); v[8 * j + 3] = bfhi(w.y); v[8 * j + 4] = bflo(w.z); v[8 * j + 5] = bfhi(w.z); v[8 * j + 6] = bflo(w.w); v[8 * j + 7] = bfhi(w.w); }
#pragma unroll
        for (int j = 0; j < 32; ++j) s += v[j];
        const float mean = wave_sum(s) * (1.f / BW); float s2 = 0.f;
#pragma unroll
        for (int j = 0; j < 32; ++j) { const float d = v[j] - mean; s2 += d * d; }
        const float rstd = 1.f / sqrtf(wave_sum(s2) * (1.f / BW) + LN_EPS);
        if (F.lane == 0) { float* st = (float*)(F.ws + WS_STAT) + 2 * m; st[0] = mean; st[1] = rstd; }
    }
}
__device__ __forceinline__ void readout_rows(Frame& F) {
    const int gw = blockIdx.x * NWAVES + F.wave, NGW = F.G * NWAVES;
    const float* of = (const float*)(F.ws + WS_OBUF); const float* ob = of + (size_t)M * AW;
    const bf16* sg = (const bf16*)(F.ws + WS_P) + 4 * pg8::SZ4;
    bf16* Y = (bf16*)(F.ws + WS_Y);
    for (int m = gw; m < M; m += NGW) {
        const int c0 = 32 * F.lane; float o[32]; float ss = 0.f;
#pragma unroll
        for (int j = 0; j < 8; ++j) { const f32x4 a = *(const GAS f32x4*)(of + (size_t)m * AW + c0 + 4 * j), b = *(const GAS f32x4*)(ob + (size_t)m * AW + c0 + 4 * j); const f32x4 t = a + b;
            o[4 * j] = t.x; o[4 * j + 1] = t.y; o[4 * j + 2] = t.z; o[4 * j + 3] = t.w; ss += (t.x * t.x + t.y * t.y) + (t.z * t.z + t.w * t.w); }
        ss += __shfl_xor(ss, 1); ss += __shfl_xor(ss, 2);
        const float r = 1.0f / sqrtf(ss * (1.f / HV) + LN_EPS);
        const int v0 = c0 & 127;
#pragma unroll
        for (int j = 0; j < 4; ++j) { const v4u g = *(const GAS v4u*)(sg + (size_t)m * AW + c0 + 8 * j); const float gg[8] = {bflo(g.x), bfhi(g.x), bflo(g.y), bfhi(g.y), bflo(g.z), bfhi(g.z), bflo(g.w), bfhi(g.w)};
            float y[8];
#pragma unroll
            for (int e = 0; e < 8; ++e) y[e] = o[8 * j + e] * r * F.a_norm_g[v0 + 8 * j + e] * gg[e];
            v4u w; w.x = pk2(y[0], y[1]); w.y = pk2(y[2], y[3]); w.z = pk2(y[4], y[5]); w.w = pk2(y[6], y[7]);
            *(GAS v4u*)(Y + pg8::tl_off(m, c0 + 8 * j, D)) = w; }
    }
}
__device__ __forceinline__ void chunkmix_naive_unit(Frame& F, int unit) {
    const int g = unit & 15, n = (unit >> 4) & 31, b = unit >> 9;
    LAS float* vn = (LAS float*)(F.lds + RING_OFF);
    LAS float* wT = vn + 128 * 128;
    const bf16* uB = (const bf16*)(F.ws + WS_P) + 4 * pg8::SZ4 + pg8::SZ3; const bf16* vB = uB + pg8::SZ3;
    const float* st = (const float*)(F.ws + WS_STAT);
    const int row0 = b * T + n * MIXC;
    for (int i = F.tid; i < 128 * 128; i += NWAVES * 64) { const int s = i >> 7, c = i & 127; const int row = row0 + s;
        const float x = bf2f(vB[(size_t)row * BW + g * 128 + c]);
        vn[i] = (x - st[2 * row]) * st[2 * row + 1] * F.v_norm_g[g * 128 + c] + F.v_norm_b[g * 128 + c];
        const int t = i >> 7, s2 = i & 127; wT[s2 * 128 + t] = F.w_s[(size_t)g * 16384 + t * 128 + s2]; }
    __syncthreads();
    const int c = F.tid & 127, t0 = (F.tid >> 7) * 32;
    float acc[32];
#pragma unroll
    for (int i = 0; i < 32; ++i) acc[i] = 0.f;
    for (int s = 0; s < 128; ++s) { const float x = vn[s * 128 + c];
#pragma unroll
        for (int i = 0; i < 32; ++i) acc[i] += wT[s * 128 + t0 + i] * x; }
    bf16* Y = (bf16*)(F.ws + WS_Y);
#pragma unroll
    for (int i = 0; i < 32; ++i) { const int t = t0 + i, row = row0 + t; const float mixed = acc[i] + F.b_s[g * 128 + t];
        const float uu = bf2f(uB[(size_t)row * BW + g * 128 + c]);
        Y[pg8::tl_off(row, 2048 + g * 128 + c, D)] = (bf16)f2bf(uu * mixed); }
    __syncthreads();
}

typedef short bf16x8 __attribute__((ext_vector_type(8)));
typedef short bf16x4 __attribute__((ext_vector_type(4)));
#define MFMA16(a, b, c) __builtin_amdgcn_mfma_f32_16x16x32_bf16((a), (b), (c), 0, 0, 0)
__device__ __forceinline__ float fexp(float x) { return __builtin_amdgcn_exp2f(x); }
__device__ __forceinline__ void gate_of(float z, float lb, float& lf, float& kk) { const float sg = sigm(z); lf = __builtin_amdgcn_logf(lb + (1.0f - lb) * sg); kk = (1.0f - lb) * (1.0f - sg); }
__device__ __forceinline__ void stage_vT(LAS bf16* VT, const bf16* vsrc, int tid) {
#pragma unroll
    for (int j = 0; j < 2; ++j) { const int idx = tid + 512 * j, sl = idx >> 4, c8 = (idx & 15) * 8; const v4u w = *(const GAS v4u*)(vsrc + (size_t)sl * AW + c8);
        VT[(c8 + 0) * 72 + sl] = (bf16)(w.x & 0xffffu); VT[(c8 + 1) * 72 + sl] = (bf16)(w.x >> 16); VT[(c8 + 2) * 72 + sl] = (bf16)(w.y & 0xffffu); VT[(c8 + 3) * 72 + sl] = (bf16)(w.y >> 16);
        VT[(c8 + 4) * 72 + sl] = (bf16)(w.z & 0xffffu); VT[(c8 + 5) * 72 + sl] = (bf16)(w.z >> 16); VT[(c8 + 6) * 72 + sl] = (bf16)(w.w & 0xffffu); VT[(c8 + 7) * 72 + sl] = (bf16)(w.w >> 16); }
}
__device__ __forceinline__ void scanA_ld(Frame& F, int unit, v4u (&zr)[2], v4u (&vr)[2]) {
    const int cidx = unit % 68; int r0 = unit / 68; const int h = r0 & 15; r0 >>= 4; const int b = r0 & 3, dir = r0 >> 2;
    const int row0 = (cidx < 4) ? (M + b * CTXL + cidx * 64) : (b * T + (cidx - 4) * 64);
    const bf16* P = (const bf16*)(F.ws + WS_P);
    const bf16* zz = P + (size_t)(2 + dir) * pg8::SZ4 + (size_t)row0 * AW + h * 128; const bf16* vv = P + pg8::SZ4 + (size_t)row0 * AW + h * 128;
#pragma unroll
    for (int j = 0; j < 2; ++j) { const int idx = F.tid + 512 * j, sl = idx >> 4, c8 = (idx & 15) * 8; zr[j] = *(const GAS v4u*)(zz + (size_t)sl * AW + c8); vr[j] = *(const GAS v4u*)(vv + (size_t)sl * AW + c8); }
}
__device__ __forceinline__ int scanA_unit_of(int l, int half) { const int per = 2 * 16 * 68, dir = l / per, r = l - dir * per; return (dir * 4 + 2 * half) * 16 * 68 + r; }
__device__ __forceinline__ void scanA_phase(Frame& F, int half) {
    int lu = blockIdx.x; if (lu >= 4352) return;
    int unit = scanA_unit_of(lu, half);
    LAS bf16* KT = (LAS bf16*)(F.lds + RING_OFF);
    LAS bf16* VT = (LAS bf16*)(F.lds + RING_OFF + 18432);
    LAS float* TOT = (LAS float*)(F.lds + RING_OFF + 36992);
    LAS bf16* ZS = (LAS bf16*)(F.lds + RING_OFF + 39040);
    v4u zr[2], vr[2];
    scanA_ld(F, unit, zr, vr);
    float lbn = ((const float*)(F.ws + WS_LB))[((unit / 68) >> 6) * 2048 + ((unit / 68) & 15) * 128 + (F.tid & 127)];
    for (; lu < 4352; lu += F.G, unit = scanA_unit_of(lu < 4352 ? lu : 0, half)) {
        const int cidx = unit % 68; int r0 = unit / 68; const int h = r0 & 15; r0 >>= 4; const int dir = r0 >> 2;
#pragma unroll
        for (int j = 0; j < 2; ++j) { const int idx = F.tid + 512 * j, sl = idx >> 4, c8 = (idx & 15) * 8; const v4u wv = vr[j];
            *(LAS v4u*)(ZS + sl * 136 + c8) = zr[j];
            LAS bf16* vp = VT + c8 * 72 + (c8 >> 4) * 8 + sl;
            vp[0 * 72] = (bf16)(wv.x & 0xffffu); vp[1 * 72] = (bf16)(wv.x >> 16); vp[2 * 72] = (bf16)(wv.y & 0xffffu); vp[3 * 72] = (bf16)(wv.y >> 16);
            vp[4 * 72] = (bf16)(wv.z & 0xffffu); vp[5 * 72] = (bf16)(wv.z >> 16); vp[6 * 72] = (bf16)(wv.w & 0xffffu); vp[7 * 72] = (bf16)(wv.w >> 16); }
        __syncthreads();
        const float lb = lbn;
        if (lu + F.G < 4352) { const int nu = scanA_unit_of(lu + F.G, half); scanA_ld(F, nu, zr, vr); lbn = ((const float*)(F.ws + WS_LB))[((nu / 68) >> 6) * 2048 + ((nu / 68) & 15) * 128 + (F.tid & 127)]; }
        const int kch = F.tid & 127, sq = F.tid >> 7;
        float lf[16], kk[16]; float tot = 0.f;
#pragma unroll
        for (int e = 0; e < 16; ++e) { gate_of(bf2f(ZS[(16 * sq + e) * 136 + kch]), lb, lf[e], kk[e]); tot += lf[e]; }
        TOT[sq * 128 + kch] = tot;
        __syncthreads();
        float aft = 0.f;
#pragma unroll
        for (int q = 0; q < 4; ++q) { const float tq = TOT[q * 128 + kch]; if (dir ? (q < sq) : (q > sq)) aft += tq; }
        float kt[16]; float run = aft;
        if (dir == 0) {
#pragma unroll
            for (int e = 15; e >= 0; --e) { kt[e] = kk[e] * fexp(run); run += lf[e]; }
        } else {
#pragma unroll
            for (int e = 0; e < 16; ++e) { kt[e] = kk[e] * fexp(run); run += lf[e]; }
        }
        { v4u w0, w1; w0.x = pk2(kt[0], kt[1]); w0.y = pk2(kt[2], kt[3]); w0.z = pk2(kt[4], kt[5]); w0.w = pk2(kt[6], kt[7]); w1.x = pk2(kt[8], kt[9]); w1.y = pk2(kt[10], kt[11]); w1.z = pk2(kt[12], kt[13]); w1.w = pk2(kt[14], kt[15]);
          LAS v4u* kp = (LAS v4u*)(KT + kch * 72 + 16 * sq); kp[0] = w0; kp[1] = w1; }
        if (sq == 0) ((float*)(F.ws + WS_DSUM))[(size_t)unit * 128 + kch] = fexp((TOT[kch] + TOT[128 + kch]) + (TOT[256 + kch] + TOT[384 + kch]));
        __syncthreads();
        const int fr = F.lane & 15, fq = F.lane >> 4, w = F.wave;
        const bf16x8 a0 = *(const LAS bf16x8*)(KT + (16 * w + fr) * 72 + 8 * fq), a1 = *(const LAS bf16x8*)(KT + (16 * w + fr) * 72 + 32 + 8 * fq);
        bf16* ST = (bf16*)(F.ws + WS_LBUF) + (size_t)unit * 16384;
#pragma unroll
        for (int vb = 0; vb < 8; ++vb) {
            const bf16x8 b0 = *(const LAS bf16x8*)(VT + (16 * vb + fr) * 72 + 8 * vb + 8 * fq), b1 = *(const LAS bf16x8*)(VT + (16 * vb + fr) * 72 + 8 * vb + 32 + 8 * fq);
            f32x4 acc = {0.f, 0.f, 0.f, 0.f}; acc = MFMA16(a0, b0, acc); acc = MFMA16(a1, b1, acc);
            v2u o; o.x = pk2(acc[0], acc[1]); o.y = pk2(acc[2], acc[3]);
            *(GAS v2u*)(ST + (size_t)(16 * vb + fr) * 128 + 16 * w + 4 * fq) = o; }
        __syncthreads();
    }
}
__device__ __forceinline__ int scanB_cidx(int dir, int step) { return dir ? (step < 4 ? 3 - step : 71 - step) : step; }
__device__ __forceinline__ void scanB(Frame& F, int half) {
    for (int cu = blockIdx.x; cu < 256; cu += F.G) {
        const int cl = cu >> 2, dir = cl >> 5, chain = (dir * 4 + 2 * half) * 16 + (cl & 31), v = (cu & 3) * 32 + (F.tid >> 4), kg = F.tid & 15;
        bf16* Lb = (bf16*)(F.ws + WS_LBUF) + (size_t)chain * 68 * 16384 + (size_t)v * 128 + 8 * kg;
        const float* Db = (const float*)(F.ws + WS_DSUM) + (size_t)chain * 68 * 128 + 8 * kg;
        float S[8];
#pragma unroll
        for (int i = 0; i < 8; ++i) S[i] = 0.f;
        v4u l0[4]; f32x4 dq[4][2];
#define SB_LOAD(slot, step_) do { const int c_ = scanB_cidx(dir, (step_) < 68 ? (step_) : 67); \
            l0[slot] = *(const GAS v4u*)(Lb + (size_t)c_ * 16384); \
            dq[slot][0] = *(const GAS f32x4*)(Db + c_ * 128); dq[slot][1] = *(const GAS f32x4*)(Db + c_ * 128 + 4); } while (0)
        SB_LOAD(0, 0); SB_LOAD(1, 1); SB_LOAD(2, 2);
        for (int s0 = 0; s0 < 68; s0 += 4) {
#pragma unroll
            for (int u = 0; u < 4; ++u) { const int step = s0 + u, cidx = scanB_cidx(dir, step);
                SB_LOAD((u + 3) & 3, step + 3);
                if (cidx >= 4) { v4u o0; o0.x = pk2(S[0], S[1]); o0.y = pk2(S[2], S[3]); o0.z = pk2(S[4], S[5]); o0.w = pk2(S[6], S[7]); *(GAS v4u*)(Lb + (size_t)cidx * 16384) = o0; }
                const float dd[8] = {dq[u][0].x, dq[u][0].y, dq[u][0].z, dq[u][0].w, dq[u][1].x, dq[u][1].y, dq[u][1].z, dq[u][1].w};
                const float ll[8] = {bflo(l0[u].x), bfhi(l0[u].x), bflo(l0[u].y), bfhi(l0[u].y), bflo(l0[u].z), bfhi(l0[u].z), bflo(l0[u].w), bfhi(l0[u].w)};
#pragma unroll
                for (int i = 0; i < 8; ++i) S[i] = dd[i] * S[i] + ll[i]; }
        }
#undef SB_LOAD
    }
}
template <int CTRL> __device__ __forceinline__ float dppf(float x) { return __builtin_bit_cast(float, __builtin_amdgcn_update_dpp(0, __builtin_bit_cast(int, x), CTRL, 0xf, 0xf, true)); }
constexpr int SC_KB = 0, SC_VT = 34816, SC_TOT = 53376, SC_SS = 61568;
__device__ __forceinline__ void scanC_dma(Frame& F, int unit) {
    const int c = unit & 63, h = (unit >> 6) & 15, b = unit >> 10, w = F.wave, fr = F.lane & 15, fq = F.lane >> 4;
#pragma unroll
    for (int j = 0; j < 8; ++j) { const int chunk = w * 8 + j, sd = chunk >> 5, v = ((chunk & 31) << 2) + fq, cp = fr;
        const bf16* src = (const bf16*)(F.ws + WS_LBUF) + ((size_t)(((sd * 4 + b) * 16 + h) * 68 + 4 + c)) * 16384 + v * 128 + ((cp ^ (v & 15)) << 3);
        __builtin_amdgcn_global_load_lds((const unsigned*)src, (LAS unsigned*)(F.lds + RING_OFF + SC_SS + chunk * 1024), 16, 0, 0); }
}
__device__ __forceinline__ void scanC_ldzv(Frame& F, int unit, v4u (&zw)[4], v4u (&vw)[2]) {
    const int c = unit & 63, h = (unit >> 6) & 15, b = unit >> 10, row0 = b * T + c * 64, w = F.wave, dir = w >> 2, tl = 16 * (w & 3) + (F.lane & 15), fq = F.lane >> 4;
    const bf16* P = (const bf16*)(F.ws + WS_P);
    const bf16* zz = P + (size_t)(2 + dir) * pg8::SZ4 + (size_t)(row0 + tl) * AW + h * 128 + 8 * fq;
#pragma unroll
    for (int kk = 0; kk < 4; ++kk) zw[kk] = *(const GAS v4u*)(zz + 32 * kk);
    const bf16* vsrc = P + pg8::SZ4 + (size_t)row0 * AW + h * 128;
#pragma unroll
    for (int j = 0; j < 2; ++j) { const int idx = F.tid + 512 * j, sl = idx >> 4, c8 = (idx & 15) * 8; vw[j] = *(const GAS v4u*)(vsrc + (size_t)sl * AW + c8); }
}
__device__ __forceinline__ void scanC_phase(Frame& F, int half) {
    const int uend = (half + 1) * 2048;
    int unit = half * 2048 + blockIdx.x; if (unit >= uend) return;
    v4u zw[4], vw[2];
    scanC_dma(F, unit); scanC_ldzv(F, unit, zw, vw);
    LAS float* LBS = (LAS float*)(F.lds + LDSCTL_OFF + 2048);
    LAS float* GNS = (LAS float*)(F.lds + LDSCTL_OFF + 4096);
    if (F.tid < 256) LBS[F.tid] = ((const float*)(F.ws + WS_LB))[(F.tid >> 7) * 2048 + ((unit >> 6) & 15) * 128 + (F.tid & 127)];
    if (F.tid < 128) GNS[F.tid] = F.a_norm_g[F.tid];
    __syncthreads();
  for (; unit < uend; unit += F.G) {
    const int nunit = unit + F.G;
    const int c = unit & 63, h = (unit >> 6) & 15, b = unit >> 10;
    const int row0 = b * T + c * 64;
    LAS bf16* KB = (LAS bf16*)(F.lds + RING_OFF + SC_KB);
    LAS bf16* VT = (LAS bf16*)(F.lds + RING_OFF + SC_VT);
    LAS float* TOT = (LAS float*)(F.lds + RING_OFF + SC_TOT);
    LAS bf16* SS = (LAS bf16*)(F.lds + RING_OFF + SC_SS);
    LAS float* OB = (LAS float*)(F.lds + RING_OFF + SC_KB);
    const bf16* P = (const bf16*)(F.ws + WS_P);
    const int w = F.wave, dir = w >> 2, i = w & 3, pi = dir ? 3 - i : i, fr = F.lane & 15, fq = F.lane >> 4, tl = 16 * i + fr;
    v4u qw[4];
    { const bf16* qq = P + (size_t)(row0 + tl) * AW + h * 128 + 8 * fq;
#pragma unroll
      for (int kk = 0; kk < 4; ++kk) qw[kk] = *(const GAS v4u*)(qq + 32 * kk); }
#pragma unroll
    for (int j = 0; j < 2; ++j) { const int idx = opq(F.tid) + 512 * j, sl = idx >> 4, c8 = (idx & 15) * 8; const v4u wv = vw[j];
        LAS bf16* vp = VT + c8 * 72 + (c8 >> 4) * 8 + sl;
        vp[0 * 72] = (bf16)(wv.x & 0xffffu); vp[1 * 72] = (bf16)(wv.x >> 16); vp[2 * 72] = (bf16)(wv.y & 0xffffu); vp[3 * 72] = (bf16)(wv.y >> 16);
        vp[4 * 72] = (bf16)(wv.z & 0xffffu); vp[5 * 72] = (bf16)(wv.z >> 16); vp[6 * 72] = (bf16)(wv.w & 0xffffu); vp[7 * 72] = (bf16)(wv.w >> 16); }
    float cum[4][8], kv[4][8];
    { const LAS float* LB = LBS + dir * 128 + 8 * (opq(F.lane) >> 4);
#pragma unroll
      for (int kk = 0; kk < 4; ++kk) { const f32x4 l0 = *(const LAS f32x4*)(LB + 32 * kk), l1 = *(const LAS f32x4*)(LB + 32 * kk + 4);
          const float lb[8] = {l0.x, l0.y, l0.z, l0.w, l1.x, l1.y, l1.z, l1.w};
          const float z[8] = {bflo(zw[kk].x), bfhi(zw[kk].x), bflo(zw[kk].y), bfhi(zw[kk].y), bflo(zw[kk].z), bfhi(zw[kk].z), bflo(zw[kk].w), bfhi(zw[kk].w)};
#pragma unroll
          for (int e = 0; e < 8; ++e) gate_of(z[e], lb[e], cum[kk][e], kv[kk][e]); } }
    if (dir == 0) {
#pragma unroll
        for (int kk = 0; kk < 4; ++kk)
#pragma unroll
            for (int e = 0; e < 8; ++e) { float x = cum[kk][e]; x += dppf<0x111>(x); x += dppf<0x112>(x); x += dppf<0x114>(x); x += dppf<0x118>(x); cum[kk][e] = x; }
    } else {
#pragma unroll
        for (int kk = 0; kk < 4; ++kk)
#pragma unroll
            for (int e = 0; e < 8; ++e) { float x = cum[kk][e]; x += dppf<0x101>(x); x += dppf<0x102>(x); x += dppf<0x104>(x); x += dppf<0x108>(x); cum[kk][e] = x; }
    }
    if (fr == (dir ? 0 : 15)) {
#pragma unroll
        for (int kk = 0; kk < 4; ++kk) { LAS f32x4* tp = (LAS f32x4*)(TOT + (dir * 4 + pi) * 128 + 32 * kk + 8 * fq);
            tp[0] = (f32x4){cum[kk][0], cum[kk][1], cum[kk][2], cum[kk][3]}; tp[1] = (f32x4){cum[kk][4], cum[kk][5], cum[kk][6], cum[kk][7]};
            tp[256] = (f32x4){fexp(cum[kk][0]), fexp(cum[kk][1]), fexp(cum[kk][2]), fexp(cum[kk][3])}; tp[257] = (f32x4){fexp(cum[kk][4]), fexp(cum[kk][5]), fexp(cum[kk][6]), fexp(cum[kk][7])}; } }
    asm volatile("s_waitcnt vmcnt(0)" ::: "memory");
    __syncthreads();
    if (nunit < uend) scanC_ldzv(F, nunit, zw, vw);
    {
#pragma unroll
      for (int kk = 0; kk < 4; ++kk) { float pre[8] = {0.f, 0.f, 0.f, 0.f, 0.f, 0.f, 0.f, 0.f};
#pragma unroll
          for (int p = 0; p < 3; ++p) if (p < pi) { const f32x4 t0 = *(const LAS f32x4*)(TOT + (dir * 4 + p) * 128 + 32 * kk + 8 * fq), t1 = *(const LAS f32x4*)(TOT + (dir * 4 + p) * 128 + 32 * kk + 8 * fq + 4);
              pre[0] += t0.x; pre[1] += t0.y; pre[2] += t0.z; pre[3] += t0.w; pre[4] += t1.x; pre[5] += t1.y; pre[6] += t1.z; pre[7] += t1.w; }
          const f32x4 m0 = *(const LAS f32x4*)(TOT + (dir * 4 + pi) * 128 + 32 * kk + 8 * fq), m1 = *(const LAS f32x4*)(TOT + (dir * 4 + pi) * 128 + 32 * kk + 8 * fq + 4);
          const float mt[8] = {m0.x, m0.y, m0.z, m0.w, m1.x, m1.y, m1.z, m1.w};
          float kt[8];
#pragma unroll
          for (int e = 0; e < 8; ++e) { const float loc = cum[kk][e]; cum[kk][e] = pre[e] + loc; kt[e] = kv[kk][e] * fexp(mt[e] - loc); }
          v4u ko; ko.x = pk2(kt[0], kt[1]); ko.y = pk2(kt[2], kt[3]); ko.z = pk2(kt[4], kt[5]); ko.w = pk2(kt[6], kt[7]);
          *(LAS v4u*)(KB + (dir * 64 + tl) * 136 + 32 * kk + 8 * fq) = ko; } }
    __syncthreads();
    float E[4][8];
    { float rpi[4][8];
#pragma unroll
      for (int kk = 0; kk < 4; ++kk)
#pragma unroll
          for (int e = 0; e < 8; ++e) rpi[kk][e] = 0.f;
#pragma unroll
      for (int p = 0; p < 4; ++p) if (p <= pi) {
#pragma unroll
          for (int kk = 0; kk < 4; ++kk) { const f32x4 r0 = *(const LAS f32x4*)(TOT + (dir * 4 + p) * 128 + 32 * kk + 8 * fq), r1 = *(const LAS f32x4*)(TOT + (dir * 4 + p) * 128 + 32 * kk + 8 * fq + 4);
              rpi[kk][0] += r0.x; rpi[kk][1] += r0.y; rpi[kk][2] += r0.z; rpi[kk][3] += r0.w; rpi[kk][4] += r1.x; rpi[kk][5] += r1.y; rpi[kk][6] += r1.z; rpi[kk][7] += r1.w; } }
#pragma unroll
      for (int kk = 0; kk < 4; ++kk)
#pragma unroll
          for (int e = 0; e < 8; ++e) E[kk][e] = fexp(cum[kk][e] - rpi[kk][e]); }
    f32x4 att[4];
#pragma unroll
    for (int pj = 3; pj >= 0; --pj) { att[pj] = (f32x4){0.f, 0.f, 0.f, 0.f};
        if (pj <= pi) { const int j = dir ? 3 - pj : pj; f32x4 d = {0.f, 0.f, 0.f, 0.f};
#pragma unroll
            for (int kk = 0; kk < 4; ++kk) {
                v4u qt; qt.x = pk2(bflo(qw[kk].x) * E[kk][0], bfhi(qw[kk].x) * E[kk][1]); qt.y = pk2(bflo(qw[kk].y) * E[kk][2], bfhi(qw[kk].y) * E[kk][3]);
                qt.z = pk2(bflo(qw[kk].z) * E[kk][4], bfhi(qw[kk].z) * E[kk][5]); qt.w = pk2(bflo(qw[kk].w) * E[kk][6], bfhi(qw[kk].w) * E[kk][7]);
                const bf16x8 a = *(const LAS bf16x8*)(KB + (dir * 64 + 16 * j + fr) * 136 + 32 * kk + 8 * fq);
                d = MFMA16(a, __builtin_bit_cast(bf16x8, qt), d);
                const f32x4 t0 = *(const LAS f32x4*)(TOT + 1024 + (dir * 4 + pj) * 128 + 32 * kk + 8 * fq), t1 = *(const LAS f32x4*)(TOT + 1024 + (dir * 4 + pj) * 128 + 32 * kk + 8 * fq + 4);
                E[kk][0] *= t0.x; E[kk][1] *= t0.y; E[kk][2] *= t0.z; E[kk][3] *= t0.w; E[kk][4] *= t1.x; E[kk][5] *= t1.y; E[kk][6] *= t1.z; E[kk][7] *= t1.w; }
            if (pj == pi) {
#pragma unroll
                for (int r = 0; r < 4; ++r) { const int sl = 4 * fq + r; if (dir ? (sl < fr) : (sl > fr)) d[r] = 0.f; } }
            att[pj] = d; } }
    f32x4 o[8];
#pragma unroll
    for (int vb = 0; vb < 8; ++vb) o[vb] = (f32x4){0.f, 0.f, 0.f, 0.f};
#pragma unroll
    for (int pp = 0; pp < 2; ++pp) if (2 * pp <= pi) {
        v4u pb; pb.x = pk2(att[2 * pp][0], att[2 * pp][1]); pb.y = pk2(att[2 * pp][2], att[2 * pp][3]); pb.z = pk2(att[2 * pp + 1][0], att[2 * pp + 1][1]); pb.w = pk2(att[2 * pp + 1][2], att[2 * pp + 1][3]);
        const int j0 = dir ? 3 - 2 * pp : 2 * pp, j1 = dir ? 2 - 2 * pp : 2 * pp + 1;
#pragma unroll
        for (int vb = 0; vb < 8; ++vb) { const v2u lo = *(const LAS v2u*)(VT + (16 * vb + fr) * 72 + 8 * vb + 16 * j0 + 4 * fq), hi = *(const LAS v2u*)(VT + (16 * vb + fr) * 72 + 8 * vb + 16 * j1 + 4 * fq);
            v4u av; av.x = lo.x; av.y = lo.y; av.z = hi.x; av.w = hi.y;
            o[vb] = MFMA16(__builtin_bit_cast(bf16x8, av), __builtin_bit_cast(bf16x8, pb), o[vb]); } }
    v2u gw[8];
    { const bf16* sg = P + 4 * pg8::SZ4 + (size_t)(row0 + tl) * AW + h * 128 + 4 * fq;
#pragma unroll
      for (int vb = 0; vb < 8; ++vb) gw[vb] = *(const GAS v2u*)(sg + 16 * vb); }
#pragma unroll
    for (int kk = 0; kk < 4; ++kk) { v4u qt; qt.x = pk2(bflo(qw[kk].x) * E[kk][0], bfhi(qw[kk].x) * E[kk][1]); qt.y = pk2(bflo(qw[kk].y) * E[kk][2], bfhi(qw[kk].y) * E[kk][3]);
        qt.z = pk2(bflo(qw[kk].z) * E[kk][4], bfhi(qw[kk].z) * E[kk][5]); qt.w = pk2(bflo(qw[kk].w) * E[kk][6], bfhi(qw[kk].w) * E[kk][7]);
#pragma unroll
        for (int vb = 0; vb < 8; ++vb) { const bf16x8 sa = *(const LAS bf16x8*)(SS + (dir * 128 + 16 * vb + fr) * 128 + (((4 * kk + fq) ^ fr) << 3));
            o[vb] = MFMA16(sa, __builtin_bit_cast(bf16x8, qt), o[vb]); } }
    __syncthreads();
    if (nunit < uend) scanC_dma(F, nunit);
    float lbq = 0.f; { const int t_ = opq(F.tid); if (nunit < uend && t_ < 256) lbq = ((const float*)(F.ws + WS_LB))[(t_ >> 7) * 2048 + ((nunit >> 6) & 15) * 128 + (t_ & 127)]; }
    if (dir == 1) {
#pragma unroll
        for (int vb = 0; vb < 8; ++vb) *(LAS f32x4*)(OB + tl * 132 + 16 * vb + 4 * fq) = o[vb]; }
    __syncthreads();
    if (dir == 0) { float ss = 0.f; const LAS float* gnp = GNS + 4 * (opq(F.lane) >> 4);
#pragma unroll
        for (int vb = 0; vb < 8; ++vb) { o[vb] += *(const LAS f32x4*)(OB + tl * 132 + 16 * vb + 4 * fq); ss += (o[vb][0] * o[vb][0] + o[vb][1] * o[vb][1]) + (o[vb][2] * o[vb][2] + o[vb][3] * o[vb][3]); }
        ss += __shfl_xor(ss, 16); ss += __shfl_xor(ss, 32);
        const float rs = 1.0f / sqrtf(ss * (1.f / HV) + LN_EPS);
        bf16* Y = (bf16*)(F.ws + WS_Y);
#pragma unroll
        for (int vb = 0; vb < 8; ++vb) { const int v0 = 16 * vb + 4 * fq; const f32x4 gn = *(const LAS f32x4*)(gnp + 16 * vb);
            v2u yo; yo.x = pk2(o[vb][0] * rs * gn.x * bflo(gw[vb].x), o[vb][1] * rs * gn.y * bfhi(gw[vb].x)); yo.y = pk2(o[vb][2] * rs * gn.z * bflo(gw[vb].y), o[vb][3] * rs * gn.w * bfhi(gw[vb].y));
            *(GAS v2u*)(Y + pg8::tl_off(row0 + tl, h * 128 + v0, D)) = yo; } }
    { const int t_ = opq(F.tid); if (nunit < uend && t_ < 256) LBS[t_] = lbq; }
    __syncthreads();
  }
}
__device__ __forceinline__ void chunkmix_unit(Frame& F, int unit) {
    const int g = unit & 15, n = (unit >> 4) & 31, b = unit >> 9;
    LAS bf16* VN = (LAS bf16*)(F.lds + RING_OFF);
    LAS bf16* WB = (LAS bf16*)(F.lds + RING_OFF + 34816);
    const bf16* uB = (const bf16*)(F.ws + WS_P) + 4 * pg8::SZ4 + pg8::SZ3; const bf16* vB = uB + pg8::SZ3;
    const float* st = (const float*)(F.ws + WS_STAT);
    const int row0 = b * T + n * MIXC;
#pragma unroll
    for (int j = 0; j < 4; ++j) { const int idx = F.tid + 512 * j, sl = idx >> 4, c8 = (idx & 15) * 8; const int row = row0 + sl;
        const v4u w = *(const GAS v4u*)(vB + (size_t)row * BW + g * 128 + c8); const float mu = st[2 * row], rs = st[2 * row + 1];
        const f32x4 g0 = *(const GAS f32x4*)(F.v_norm_g + g * 128 + c8), g1 = *(const GAS f32x4*)(F.v_norm_g + g * 128 + c8 + 4), b0 = *(const GAS f32x4*)(F.v_norm_b + g * 128 + c8), b1 = *(const GAS f32x4*)(F.v_norm_b + g * 128 + c8 + 4);
        const float x[8] = {bflo(w.x), bfhi(w.x), bflo(w.y), bfhi(w.y), bflo(w.z), bfhi(w.z), bflo(w.w), bfhi(w.w)};
        const float gg[8] = {g0.x, g0.y, g0.z, g0.w, g1.x, g1.y, g1.z, g1.w}, bb[8] = {b0.x, b0.y, b0.z, b0.w, b1.x, b1.y, b1.z, b1.w};
#pragma unroll
        for (int e = 0; e < 8; ++e) VN[(c8 + e) * 136 + sl] = (bf16)f2bf((x[e] - mu) * rs * gg[e] + bb[e]); }
#pragma unroll
    for (int j = 0; j < 4; ++j) { const int idx = F.tid + 512 * j, t = idx >> 4, s8 = (idx & 15) * 8; const float* wp = F.w_s + (size_t)g * 16384 + t * 128 + s8;
        const f32x4 a = *(const GAS f32x4*)wp, c = *(const GAS f32x4*)(wp + 4); v4u o; o.x = pk2(a.x, a.y); o.y = pk2(a.z, a.w); o.z = pk2(c.x, c.y); o.w = pk2(c.z, c.w);
        *(LAS v4u*)(WB + t * 136 + s8) = o; }
    __syncthreads();
    const int w = F.wave, fr = F.lane & 15, fq = F.lane >> 4;
    bf16x8 af[4];
#pragma unroll
    for (int ks = 0; ks < 4; ++ks) af[ks] = *(const LAS bf16x8*)(VN + (16 * w + fr) * 136 + 32 * ks + 8 * fq);
    bf16* Y = (bf16*)(F.ws + WS_Y);
#pragma unroll
    for (int tb = 0; tb < 8; ++tb) { f32x4 acc = {0.f, 0.f, 0.f, 0.f};
#pragma unroll
        for (int ks = 0; ks < 4; ++ks) acc = MFMA16(af[ks], *(const LAS bf16x8*)(WB + (16 * tb + fr) * 136 + 32 * ks + 8 * fq), acc);
        const int t = 16 * tb + fr, row = row0 + t, c0 = g * 128 + 16 * w + 4 * fq; const float bs = F.b_s[g * 128 + t];
        const v2u uw = *(const GAS v2u*)(uB + (size_t)row * BW + c0);
        v2u yo; yo.x = pk2(bflo(uw.x) * (acc[0] + bs), bfhi(uw.x) * (acc[1] + bs)); yo.y = pk2(bflo(uw.y) * (acc[2] + bs), bfhi(uw.y) * (acc[3] + bs));
        *(GAS v2u*)(Y + pg8::tl_off(row, 2048 + c0, D)) = yo; }
    __syncthreads();
}

__device__ __forceinline__ void mix_ld(Frame& F, int unit, v4u (&vw)[4], float (&mu)[4], float (&rs)[4], v2u (&uw)[8]) {
    const int g = unit & 15, n = (unit >> 4) & 31, b = unit >> 9, row0 = b * T + n * MIXC, c8 = (F.tid & 15) * 8;
    { const bf16* uB = (const bf16*)(F.ws + WS_P) + 4 * pg8::SZ4 + pg8::SZ3; const int w = F.wave, fr = F.lane & 15, fq = F.lane >> 4;
#pragma unroll
      for (int tb = 0; tb < 8; ++tb) uw[tb] = *(const GAS v2u*)(uB + (size_t)(row0 + 16 * tb + fr) * BW + g * 128 + 16 * w + 4 * fq); }
    const bf16* vB = (const bf16*)(F.ws + WS_P) + 4 * pg8::SZ4 + 2 * pg8::SZ3; const float* st = (const float*)(F.ws + WS_STAT);
#pragma unroll
    for (int j = 0; j < 4; ++j) { const int row = row0 + ((F.tid + 512 * j) >> 4); vw[j] = *(const GAS v4u*)(vB + (size_t)row * BW + g * 128 + c8); mu[j] = st[2 * row]; rs[j] = st[2 * row + 1]; }
}
__device__ __forceinline__ void chunkmix_phase(Frame& F) {
    constexpr int NU = NB * 32 * NG;
    int unit = blockIdx.x; if (unit >= NU) return;
    LAS bf16* VN = (LAS bf16*)(F.lds + RING_OFF);
    LAS bf16* WB = (LAS bf16*)(F.lds + RING_OFF + 34944);
    const bf16* uB = (const bf16*)(F.ws + WS_P) + 4 * pg8::SZ4 + pg8::SZ3;
    bf16* Y = (bf16*)(F.ws + WS_Y);
    const int w = F.wave, fr = F.lane & 15, fq = F.lane >> 4, c8 = (F.tid & 15) * 8;
    int gcur = -1; float gg[8], bb[8], bs[8];
    v4u vw[4]; float mu[4], rs[4]; v2u un[8];
    mix_ld(F, unit, vw, mu, rs, un);
    for (; unit < NU; unit += F.G) {
        const int g = unit & 15, n = (unit >> 4) & 31, b = unit >> 9, row0 = b * T + n * MIXC;
        if (g != gcur) { gcur = g;
#pragma unroll
            for (int j = 0; j < 4; ++j) { const int idx = F.tid + 512 * j, t = idx >> 4, s8 = (idx & 15) * 8; const float* wp = F.w_s + (size_t)g * 16384 + t * 128 + s8;
                const f32x4 a = *(const GAS f32x4*)wp, c = *(const GAS f32x4*)(wp + 4); v4u o; o.x = pk2(a.x, a.y); o.y = pk2(a.z, a.w); o.z = pk2(c.x, c.y); o.w = pk2(c.z, c.w);
                *(LAS v4u*)(WB + t * 136 + s8) = o; }
            const f32x4 g0 = *(const GAS f32x4*)(F.v_norm_g + g * 128 + c8), g1 = *(const GAS f32x4*)(F.v_norm_g + g * 128 + c8 + 4), b0 = *(const GAS f32x4*)(F.v_norm_b + g * 128 + c8), b1 = *(const GAS f32x4*)(F.v_norm_b + g * 128 + c8 + 4);
            gg[0] = g0.x; gg[1] = g0.y; gg[2] = g0.z; gg[3] = g0.w; gg[4] = g1.x; gg[5] = g1.y; gg[6] = g1.z; gg[7] = g1.w;
            bb[0] = b0.x; bb[1] = b0.y; bb[2] = b0.z; bb[3] = b0.w; bb[4] = b1.x; bb[5] = b1.y; bb[6] = b1.z; bb[7] = b1.w;
#pragma unroll
            for (int tb = 0; tb < 8; ++tb) bs[tb] = F.b_s[g * 128 + 16 * tb + fr]; }
#pragma unroll
        for (int j = 0; j < 4; ++j) { const int sl = (F.tid + 512 * j) >> 4; const v4u wv = vw[j];
            const float x[8] = {bflo(wv.x), bfhi(wv.x), bflo(wv.y), bfhi(wv.y), bflo(wv.z), bfhi(wv.z), bflo(wv.w), bfhi(wv.w)};
            LAS bf16* vp = VN + c8 * 136 + (c8 >> 4) * 8 + sl;
#pragma unroll
            for (int e = 0; e < 8; ++e) vp[e * 136] = (bf16)f2bf((x[e] - mu[j]) * rs[j] * gg[e] + bb[e]); }
        __syncthreads();
        v2u uw[8];
#pragma unroll
        for (int tb = 0; tb < 8; ++tb) uw[tb] = un[tb];
        if (unit + F.G < NU) mix_ld(F, unit + F.G, vw, mu, rs, un);
        bf16x8 af[4];
#pragma unroll
        for (int ks = 0; ks < 4; ++ks) af[ks] = *(const LAS bf16x8*)(VN + (16 * w + fr) * 136 + 8 * w + 32 * ks + 8 * fq);
#pragma unroll
        for (int tb = 0; tb < 8; ++tb) { f32x4 acc = {0.f, 0.f, 0.f, 0.f};
#pragma unroll
            for (int ks = 0; ks < 4; ++ks) acc = MFMA16(af[ks], *(const LAS bf16x8*)(WB + (16 * tb + fr) * 136 + 32 * ks + 8 * fq), acc);
            const int row = row0 + 16 * tb + fr, c0 = g * 128 + 16 * w + 4 * fq;
            v2u yo; yo.x = pk2(bflo(uw[tb].x) * (acc[0] + bs[tb]), bfhi(uw[tb].x) * (acc[1] + bs[tb])); yo.y = pk2(bflo(uw[tb].y) * (acc[2] + bs[tb]), bfhi(uw[tb].y) * (acc[3] + bs[tb]));
            *(GAS v2u*)(Y + pg8::tl_off(row, 2048 + c0, D)) = yo; }
        __syncthreads();
    }
}

__device__ __forceinline__ void ln1_process(Frame& F, int lane, int m, f32x4 (&v)[16], float* stats, bf16* ho) {
    float s = 0.f;
#pragma unroll
    for (int j = 0; j < 16; ++j) s += (v[j].x + v[j].y) + (v[j].z + v[j].w);
    const float mean = wave_sum(s) * (1.f / D); float s2 = 0.f;
#pragma unroll
    for (int j = 0; j < 16; ++j) { const f32x4 d = v[j] - mean; s2 += (d.x * d.x + d.y * d.y) + (d.z * d.z + d.w * d.w); }
    float rstd = 1.f / sqrtf(wave_sum(s2) * (1.f / D) + LN_EPS);
    if (lane == 0) { stats[2 * m] = mean; stats[2 * m + 1] = rstd; }
    const GAS f32x4* g1 = (const GAS f32x4*)opqp(F.ln1_g) + lane; const GAS f32x4* b1 = (const GAS f32x4*)opqp(F.ln1_b) + lane;
#pragma unroll
    for (int j = 0; j < 16; ++j) { v[j] = (v[j] - mean) * rstd * g1[64 * j] + b1[64 * j]; if ((j & 3) == 3) asm volatile("" ::: "memory"); }
    rstd = ln_center(v);
    const float* mod = (const float*)(F.ws + WS_MODX) + (size_t)(m >> 12) * 24576;
    const GAS f32x4* sh = (const GAS f32x4*)opqp(mod + 3 * 4096) + lane; const GAS f32x4* sc = (const GAS f32x4*)opqp(mod + 4 * 4096) + lane;
    float amax = 0.f;
#pragma unroll
    for (int j = 0; j < 16; ++j) { const f32x4 a = sh[64 * j], b = sc[64 * j]; v[j] = v[j] * rstd * (b + 1.0f) + a;
        amax = fmaxf(amax, fmaxf(fmaxf(fabsf(v[j].x), fabsf(v[j].y)), fmaxf(fabsf(v[j].z), fabsf(v[j].w)))); if ((j & 3) == 3) asm volatile("" ::: "memory"); }
    amax = wave_max(amax);
    amax = fmaxf(amax, 1e-20f);
    if (lane == 0) ((float*)(F.ws + WS_SA2))[m] = amax * (1.0f / 127.0f);
    const float inv = 127.0f / amax;
    unsigned char* const ob = (unsigned char*)ho + pg8::tl_off(m, 2 * lane, 2048) * 2;
#pragma unroll
    for (int j = 0; j < 16; ++j) *(GAS unsigned*)(ob + (size_t)j * 2 * 16384 * 2) = pack_i8(v[j].x * inv, v[j].y * inv, v[j].z * inv, v[j].w * inv);
}
__device__ __forceinline__ void ln1_process_l(Frame& F, int lane_, int m, f32x4 (&v)[16], float* stats, bf16* ho, const LAS float* V) {
    const int lane = opq(lane_);
    float s = 0.f;
#pragma unroll
    for (int j = 0; j < 16; ++j) s += (v[j].x + v[j].y) + (v[j].z + v[j].w);
    const float mean = wave_sum(s) * (1.f / D); float s2 = 0.f;
#pragma unroll
    for (int j = 0; j < 16; ++j) { const f32x4 d = v[j] - mean; s2 += (d.x * d.x + d.y * d.y) + (d.z * d.z + d.w * d.w); }
    float rstd = 1.f / sqrtf(wave_sum(s2) * (1.f / D) + LN_EPS);
    if (lane == 0) { stats[2 * m] = mean; stats[2 * m + 1] = rstd; }
    const LAS f32x4* g1 = (const LAS f32x4*)V + lane; const LAS f32x4* b1 = g1 + 1024; const LAS f32x4* sh = g1 + 2048; const LAS f32x4* sc = g1 + 3072;
#pragma unroll
    for (int j = 0; j < 16; ++j) v[j] = (v[j] - mean) * rstd * g1[64 * j] + b1[64 * j];
    rstd = ln_center(v);
    float amax = 0.f;
#pragma unroll
    for (int j = 0; j < 16; ++j) { const f32x4 a = sh[64 * j], b = sc[64 * j]; v[j] = v[j] * rstd * (b + 1.0f) + a;
        amax = fmaxf(amax, fmaxf(fmaxf(fabsf(v[j].x), fabsf(v[j].y)), fmaxf(fabsf(v[j].z), fabsf(v[j].w)))); }
    amax = wave_max(amax);
    amax = fmaxf(amax, 1e-20f);
    if (lane == 0) ((float*)(F.ws + WS_SA2))[m] = amax * (1.0f / 127.0f);
    const float inv = 127.0f / amax;
    unsigned char* const ob = (unsigned char*)ho + pg8::tl_off(m, 2 * lane, 2048) * 2;
#pragma unroll
    for (int j = 0; j < 16; ++j) *(GAS unsigned*)(ob + (size_t)j * 2 * 16384 * 2) = pack_i8(v[j].x * inv, v[j].y * inv, v[j].z * inv, v[j].w * inv);
}
__device__ __forceinline__ void ln1_rows(Frame& F, float* xo, bf16* ho) {
    const int gw = blockIdx.x * NWAVES + F.wave, NGW = F.G * NWAVES; const int lane = opq(F.tid & 63);
    LAS float* V = (LAS float*)(F.lds + RING_OFF);
    for (int i = F.tid; i < 1024; i += NWAVES * 64) { ((LAS f32x4*)V)[i] = ((const GAS f32x4*)F.ln1_g)[i]; ((LAS f32x4*)V)[1024 + i] = ((const GAS f32x4*)F.ln1_b)[i]; }
    f32x4 a[16], b[16];
    for (int seg = 0; seg < 4; ++seg) {
        const int base = seg * 4096, r0 = gw, r1 = gw + NGW;
        if (r0 < 4096) ld_row16(F.out + (size_t)(base + r0) * D, lane, a);
        if (r1 < 4096) ld_row16(F.out + (size_t)(base + r1) * D, lane, b);
        const float* mod = (const float*)(F.ws + WS_MODX) + (size_t)seg * 24576 + 3 * 4096;
        for (int i = F.tid; i < 2048; i += NWAVES * 64) ((LAS f32x4*)V)[2048 + i] = ((const GAS f32x4*)mod)[i];
        __syncthreads();
        for (int r = r0; r < 4096; r += 2 * NGW) {
            if (r != r0) { ld_row16(F.out + (size_t)(base + r) * D, lane, a); if (r + NGW < 4096) ld_row16(F.out + (size_t)(base + r + NGW) * D, lane, b); }
            ln1_process_l(F, lane, base + r, a, xo, ho, V);
            if (r + NGW < 4096) ln1_process_l(F, lane, base + r + NGW, b, xo, ho, V); }
        __syncthreads();
    }
}
__device__ __forceinline__ void ln2_process(Frame& F, int lane, int m, f32x4 (&v)[16], float* xo) {
    const float rstd = ln_center(v);
    const GAS f32x4* g1 = (const GAS f32x4*)opqp(F.ln2_g) + lane; const GAS f32x4* b1 = (const GAS f32x4*)opqp(F.ln2_b) + lane;
    GAS f32x4* xw = (GAS f32x4*)(xo + (size_t)m * D) + lane;
#pragma unroll
    for (int j = 0; j < 16; ++j) xw[64 * j] = v[j] * rstd * g1[64 * j] + b1[64 * j];
}
__device__ __forceinline__ void ln2_rows(Frame& F, float* xo) {
    const int gw = blockIdx.x * NWAVES + F.wave, NGW = F.G * NWAVES;
    f32x4 a[16], b[16]; const int lane = opq(F.tid & 63);
    if (gw < M) ld_row16(F.out + (size_t)gw * D, lane, a);
    for (int m = gw; m < M; m += 2 * NGW) { const int m1 = m + NGW, m2 = m + 2 * NGW;
        if (m1 < M) ld_row16(F.out + (size_t)m1 * D, lane, b);
        ln2_process(F, lane, m, a, xo);
        if (m1 < M) { if (m2 < M) ld_row16(F.out + (size_t)m2 * D, lane, a); ln2_process(F, lane, m1, b, xo); } }
}

constexpr int NPHASE = 12;
struct Args { const float* in[22]; float* out; unsigned char* ws; int ph_lo, ph_hi; };
__global__ void __launch_bounds__(NWAVES * 64, 2) mk_fwd(Args args) {
    extern __shared__ __attribute__((aligned(16))) unsigned char lds[];
    Frame F;
    F.lds = (LAS unsigned char*)lds;
    F.MISC = (volatile LAS unsigned*)(F.lds + MISC_OFF);
    F.tid = threadIdx.x; F.lane = F.tid & 63; F.wave = __builtin_amdgcn_readfirstlane(F.tid >> 6);
    F.G = gridDim.x;
    unsigned char* ws = args.ws; F.ws = ws; F.out = args.out;
    F.ctl = (gu32*)(ws + WS_CTL);
    F.x = args.in[0]; F.c = args.in[1]; F.ctx = args.in[2]; F.c_ctx = args.in[3]; F.w_ada = args.in[4]; F.b_ada = args.in[5]; F.w_in = args.in[6]; F.lbl = args.in[7];
    F.a_norm_g = args.in[8]; F.w_proj_a = args.in[9]; F.v_norm_g = args.in[10]; F.v_norm_b = args.in[11]; F.w_s = args.in[12]; F.b_s = args.in[13]; F.w_proj_b = args.in[14];
    F.w_out = args.in[15]; F.ln1_g = args.in[16]; F.ln1_b = args.in[17]; F.w_ff1 = args.in[18]; F.w_ff2 = args.in[19]; F.ln2_g = args.in[20]; F.ln2_b = args.in[21];
    for (int u = F.tid; u < (LDS_BYTES - LDSCTL_OFF) / 4; u += NWAVES * 64) ((LAS unsigned*)(F.lds + LDSCTL_OFF))[u] = 0u;
    __syncthreads();
    const int lo = args.ph_lo, hi = args.ph_hi;
    XcdBarrier bar; bar.bar = (unsigned*)(F.ctl + CW_BAR); bar.x = 0; bar.st = nullptr;
    if (hi - lo > 1) bar = xcd_barrier_post((unsigned*)(F.ctl + CW_BAR), F.MISC + 8);
#define IN(k) (lo <= (k) && (k) < hi)
#define SEAM(k) do { if (IN(k) && IN((k) + 1)) xcd_barrier(bar); } while (0)
    bf16* const P = (bf16*)(ws + WS_P);
    bf16* const HB = (bf16*)(ws + WS_HBUF);
    bf16* const Y = (bf16*)(ws + WS_Y);
    const float* const MODX = (const float*)(ws + WS_MODX);

    if (IN(0)) { REPS(0) { p0_prologue(F); __syncthreads(); } } SEAM(0);
    if (IN(1)) { REPS(1) p1_rows(F); } SEAM(1);
    if (IN(2)) {
        if constexpr (!I8_U) { pg8::Gemm g{pg8::tiled(HB, D), pg8::tiled((const bf16*)(ws + WS_WINB), D), D}; pg8::StaticOrder S; S.init(M / 256, I8_GV ? 8 : 24, F.G, (int)blockIdx.x); S.pnoff = I8_GV ? 8 : 0;
          pg8::EpiInProj E{P};
          pg8::gemm_phase<pg8::EpiInProj, pg8::StaticOrder, PG8_ALIGN, PG8_SP2>(F.lds + RING_OFF, g, S, E); }
        { pg8::Gemm g{pg8::tiled((const bf16*)(ws + WS_H8), 2048), pg8::tiled((const bf16*)(ws + WS_WIN8), 2048), 2048}; pg8::StaticOrder S; S.init(M / 256, 64 + I8_GV * 16 + I8_U * 8 - FP8_T0, F.G, (int)blockIdx.x, MC / 256, 24); S.pnoff = FP8_T0; S.expn0 = 8;
          pg8::EpiInProj8 E{P, (const LAS float*)(F.lds + LDSCTL_OFF + 8192)}; pg8::MidScales MS{(const float*)(ws + WS_SA1), (const float*)(ws + WS_SB0), F.lds + LDSCTL_OFF + 8192};
          pg8::gemm_phase<pg8::EpiInProj8, pg8::StaticOrder, PG8_ALIGN, PG8_SP2, pg8::MidScales, 2>(F.lds + RING_OFF, g, S, E, MS); }
    } SEAM(2);
#if PROBE_DUP == 20
    if (IN(2) && IN(3)) { for (int q = 0; q < 20; ++q) xcd_barrier(bar); }
#endif
    if (IN(3)) { vb_stats_rows(F); } SEAM(3);
    if (IN(4)) {
        chunkmix_phase(F);
        scanA_phase(F, 0);
        if (hi - lo > 1) xcd_barrier(bar);
        scanB(F, 0);
        if (hi - lo > 1) xcd_barrier(bar);
        scanC_phase(F, 0);
        scanA_phase(F, 1);
        if (hi - lo > 1) xcd_barrier(bar);
        scanB(F, 1);
        if (hi - lo > 1) xcd_barrier(bar);
        scanC_phase(F, 1);
    }
    if (IN(4) && IN(6)) xcd_barrier(bar);
    if (IN(6)) {
        pg8::StaticOrder S; S.init(M / 256, D / 256, F.G, (int)blockIdx.x);
        const bf16* PG = P + 4 * pg8::SZ4 + 3 * pg8::SZ3;
        pg8::Gemm g{pg8::tiled(Y, D), pg8::tiled((const bf16*)(ws + WS_WPAB), D), D}; pg8::EpiMerge<false> E{PG, 1, HB}; pg8::MidRatio MH{PG};
        pg8::gemm_phase<pg8::EpiMerge<false>, pg8::StaticOrder, PG8_ALIGN, PG8_SP2, pg8::MidRatio>(F.lds + RING_OFF, g, S, E, MH);
    } SEAM(6);
    if (IN(7)) {
        pg8::Gemm g{pg8::tiled(HB, D), pg8::tiled((const bf16*)(ws + WS_WOUT), D), D}; pg8::StaticOrder S; S.init(M / 256, D / 256, F.G, (int)blockIdx.x);
#if PROBE_DUP == 7
        { pg8::EpiResid<1> E0{F.x, MODX + 2 * 4096, ALPHA, (float*)(ws + WS_ABUF), (const float*)(ws + WS_ETAB), nullptr, nullptr, nullptr}; pg8::gemm_phase<pg8::EpiResid<1>, pg8::StaticOrder, PG8_ALIGN, PG8_SP2>(F.lds + RING_OFF, g, S, E0); }
#endif
        pg8::EpiResid<1> E{F.x, MODX + 2 * 4096, ALPHA, F.out, (const float*)(ws + WS_ETAB), nullptr, nullptr, nullptr};
        pg8::gemm_phase<pg8::EpiResid<1>, pg8::StaticOrder, PG8_ALIGN, PG8_SP2>(F.lds + RING_OFF, g, S, E);
    } SEAM(7);
    if (IN(8)) {
#if PROBE_DUP == 8
        ln1_rows(F, (float*)(ws + WS_WOUT), (bf16*)(ws + WS_Y));
#endif
        ln1_rows(F, (float*)(ws + WS_ST1), HB); REPS(15) ff_weight_copies(F); } SEAM(8);
    if (IN(9)) {
        pg8::Gemm g{pg8::tiled(HB, 2048), pg8::tiled((const bf16*)(ws + WS_WFF1), 2048), 2048}; pg8::StaticOrder S; S.init(M / 256, DFF / 256, F.G, (int)blockIdx.x);
        pg8::EpiRelu2Q E{(bf16*)(ws + WS_ABUF), DFF, (const LAS float*)(F.lds + LDSCTL_OFF + 8192)}; pg8::MidScales MS{(const float*)(ws + WS_SA2), (const float*)(ws + WS_SB1), F.lds + LDSCTL_OFF + 8192};
        pg8::gemm_phase<pg8::EpiRelu2Q, pg8::StaticOrder, PG8_ALIGN, PG8_SP2, pg8::MidScales, 2>(F.lds + RING_OFF, g, S, E, MS);
    } SEAM(9);
    if (IN(10)) {
        pg8::Gemm g{pg8::tiled((const bf16*)(ws + WS_ABUF), DFF), pg8::tiled((const bf16*)(ws + WS_WFF2), DFF), DFF}; pg8::StaticOrder S; S.init(M / 256, D / 256, F.G, (int)blockIdx.x, 0, 0, FF2_WGM);
#if PROBE_DUP == 10
        { pg8::EpiResid<2> E0{F.out, MODX + 5 * 4096, ALPHA, (float*)(ws + WS_WIN), nullptr, (const float*)(ws + WS_ST1), F.ln1_g, F.ln1_b}; pg8::gemm_phase<pg8::EpiResid<2>, pg8::StaticOrder, PG8_ALIGN, PG8_SP2>(F.lds + RING_OFF, g, S, E0); }
#endif
        pg8::EpiResidLn E{F.out, ALPHA, F.out, (const LAS float*)(F.lds + LDSCTL_OFF + 8192)}; pg8::MidLn ML{MODX + 5 * 4096, F.ln1_g, F.ln1_b, (const float*)(ws + WS_ST1), F.lds + LDSCTL_OFF + 8192};
        pg8::gemm_phase<pg8::EpiResidLn, pg8::StaticOrder, PG8_ALIGN, PG8_SP2, pg8::MidLn>(F.lds + RING_OFF, g, S, E, ML);
    } SEAM(10);
    if (IN(11)) {
#if PROBE_DUP == 11
        ln2_rows(F, (float*)(ws + WS_WIN));
#endif
        ln2_rows(F, F.out);
#if PROBE_DUP == 21
        xcd_barrier(bar); p0_prologue(F);
#endif
    }
#undef IN
#undef SEAM
}

extern "C" void kernel_launch(void* const* d_in, const int* in_sizes, int n_in, void* d_out, int out_size, void* d_ws, size_t ws_size, hipStream_t stream) {
    static int grid = 0;
    if (grid == 0) {
        if (n_in != 22 || in_sizes[0] != M * D || out_size != M * D || ws_size < WS_END) { fprintf(stderr, "kernel_launch: unexpected shapes (n_in %d, in0 %d, out %d, ws %zu < %zu); nothing launched\n", n_in, n_in > 0 ? in_sizes[0] : -1, out_size, ws_size, (size_t)WS_END); grid = -1; return; }
        int dev = 0, cus = 0, per_cu = 0;
        if (hipGetDevice(&dev) != hipSuccess || hipDeviceGetAttribute(&cus, hipDeviceAttributeMultiprocessorCount, dev) != hipSuccess) { grid = -1; return; }
        if (hipFuncSetAttribute((const void*)mk_fwd, hipFuncAttributeMaxDynamicSharedMemorySize, LDS_BYTES) != hipSuccess) { fprintf(stderr, "kernel_launch: hipFuncSetAttribute failed\n"); grid = -1; return; }
        if (hipOccupancyMaxActiveBlocksPerMultiprocessor(&per_cu, (const void*)mk_fwd, NWAVES * 64, LDS_BYTES) != hipSuccess || per_cu < 1) { fprintf(stderr, "kernel_launch: occupancy query reports %d blocks per CU\n", per_cu); }
        (void)hipGetLastError();
        grid = cus;
    }
    if (grid < 0) return;
    if (hipMemsetAsync((char*)d_ws + WS_CTL, 0, CTL_ZERO_BYTES, stream) != hipSuccess) { fprintf(stderr, "kernel_launch: memset failed\n"); return; }
    Args a{};
    for (int i = 0; i < 22; ++i) a.in[i] = (const float*)d_in[i];
    a.out = (float*)d_out; a.ws = (unsigned char*)d_ws;
#if MK_N_LAUNCHES == 1
    a.ph_lo = 0; a.ph_hi = NPHASE;
    hipLaunchKernelGGL(mk_fwd, dim3(grid), dim3(NWAVES * 64), LDS_BYTES, stream, a);
#else
    for (int p = 0; p < NPHASE; ++p) { a.ph_lo = p; a.ph_hi = p + 1; hipLaunchKernelGGL(mk_fwd, dim3(grid), dim3(NWAVES * 64), LDS_BYTES, stream, a); }
#endif
    const hipError_t le = hipPeekAtLastError();
    if (le != hipSuccess) fprintf(stderr, "kernel_launch: launch failed: %s\n", hipGetErrorName(le));
}
```

```cpp
#include <hip/hip_runtime.h>
#include <cstdio>
#include <cstdint>

#ifndef SCAN_NAIVE
#define SCAN_NAIVE 0
#endif
#ifndef MIX_NAIVE
#define MIX_NAIVE 0
#endif
#ifndef PG8_AUX
#define PG8_AUX 0
#endif
#ifndef FF2_WGM
#define FF2_WGM 4
#endif
#ifndef FP8_T0
#define FP8_T0 0
#endif
#ifndef BF_T0
#define BF_T0 0
#endif
#ifndef I8_GV
#define I8_GV 1
#endif
#ifndef I8_U
#define I8_U 1
#endif
#ifndef PROBE_DUP
#define PROBE_DUP -1
#endif
#define REPS(k) for (int rep_ = 0; rep_ < ((PROBE_DUP == (k)) ? 2 : 1); ++rep_)
#ifndef MK_N_LAUNCHES
#define MK_N_LAUNCHES 1
#endif

namespace pg8 {
#define PG8_LAS __attribute__((address_space(3)))
typedef unsigned short bf16_t;
typedef short bf16x8 __attribute__((ext_vector_type(8)));
typedef float f32x4 __attribute__((ext_vector_type(4)));
typedef unsigned u32x4 __attribute__((ext_vector_type(4)));
typedef int v4i32 __attribute__((ext_vector_type(4)));
constexpr int BM = 256, BK = 64, HALF = 128, HTB = HALF * BK * 2, STAGE_BYTES = 8 * HTB, NXCD = 8, WGM = 8;

__host__ __device__ __forceinline__ int lds_byte(int r, int c) { const int st = (r >> 4) * 2 + (c >> 5), rr = r & 15, cc = c & 31, ob = rr * 64 + cc * 2; return st * 1024 + (ob ^ (((ob >> 9) & 1) << 5)); }
__host__ __device__ __forceinline__ void stage_rc(int b, int& R, int& C) { const int st = b / 1024, sb = b % 1024, swz = sb ^ (((sb >> 9) & 1) << 5); R = (st >> 1) * 16 + swz / 64; C = (st & 1) * 32 + (swz % 64) / 2; }
__host__ __device__ __forceinline__ int perm32(int rho) { const int n = rho >> 4, i = rho & 15; return 8 * (i >> 2) + 4 * n + (i & 3); }

struct Unit { int pm, pn; };
struct Operand { const bf16_t* p; unsigned rowpitch; size_t kstep, hstep, tstep; };
__host__ __device__ __forceinline__ size_t tl_off(int r, int c, int ldk) { return ((size_t)(r >> 8) * (size_t)(ldk >> 6) + (size_t)(c >> 6)) * 16384 + (size_t)(((r >> 7) & 1) * 8192 + (lds_byte(r & 127, c & 63) >> 1)); }
__host__ __device__ __forceinline__ int invperm32(int x) { return 16 * ((x >> 2) & 1) + 4 * (x >> 3) + (x & 3); }
__host__ __device__ __forceinline__ size_t tl_off_b(int n, int c, int ldk, bool perm) { return tl_off(perm ? ((n & ~31) + invperm32(n & 31)) : n, c, ldk); }
__host__ __device__ __forceinline__ Operand tiled(const bf16_t* base, int ldk, int col0 = 0) { Operand o; o.p = base + (size_t)(col0 >> 6) * 16384; o.rowpitch = 0; o.kstep = 32768; o.hstep = 16384; o.tstep = (size_t)(ldk >> 6) * 32768; return o; }
__host__ __device__ __forceinline__ Operand rowmajor(const bf16_t* base, int ld) { Operand o; o.p = base; o.rowpitch = (unsigned)ld; o.kstep = 128; o.hstep = (size_t)128 * ld * 2; o.tstep = (size_t)256 * ld * 2; return o; }
struct Gemm { Operand A, B; int K; };

struct StaticOrder {
    int nM, nN, nwg, G, c, nex, exM, wgm, pnoff = 0, gap_at = 1 << 30, gap_n = 0, expn0 = 0;
    __device__ void init(int nM_, int nN_, int G_, int c_, int exM_ = 0, int exN_ = 0, int wgm_ = WGM) { nM = nM_; nN = nN_; nwg = nM * nN; G = G_; c = c_; exM = exM_; nex = exM_ * exN_; wgm = wgm_; }
    __device__ bool next(int i, Unit& u) const {
        const long L = (long)i * G + c; if (L >= nwg + nex) return false;
        if (L >= nwg) { const int idx = (int)L - nwg; u.pm = nM + idx % exM; u.pn = idx / exM + expn0; return true; }
        int wgid = (int)L; { const int q = nwg / NXCD, r = nwg % NXCD, xcd = wgid % NXCD, off = wgid / NXCD; wgid = (xcd < r ? xcd * (q + 1) : r * (q + 1) + (xcd - r) * q) + off; }
        const int nig = wgm * nN, gid = wgid / nig, fm = gid * wgm, gsz = (nM - fm) < wgm ? (nM - fm) : wgm;
        u.pm = fm + ((wgid % nig) % gsz); u.pn = (wgid % nig) / gsz + pnoff; if (u.pn >= gap_at) u.pn += gap_n; return true;
    }
    __device__ __forceinline__ void a_ready(const Unit&) const {}
    __device__ __forceinline__ void done(const Unit&) const {}
};

__device__ __forceinline__ unsigned cvt_pk_bf16(float lo, float hi) { unsigned r; asm volatile("v_cvt_pk_bf16_f32 %0, %1, %2" : "=v"(r) : "v"(lo), "v"(hi)); return r; }
__device__ __forceinline__ float bflo(unsigned w) { return __uint_as_float(w << 16); }
__device__ __forceinline__ float bfhi(unsigned w) { return __uint_as_float(w & 0xffff0000u); }
__device__ __forceinline__ float sigm(float v) { return __builtin_amdgcn_rcpf(1.0f + __expf(-v)); }

constexpr size_t SZ4 = (size_t)17408 * 2048, SZ3 = (size_t)16384 * 2048, SZG = (size_t)16384 * 4096;
struct EpiInProj {
    static constexpr bool PERM = true, AFTER_DRAIN = false;
    bf16_t* P;
    __device__ __forceinline__ void operator()(const f32x4 (&acc)[2][2][4][2], const Unit& u, int wr, int wc, int fr, int fq) const {
        const int seg = u.pn >> 3; bf16_t* base = P + 4 * SZ4 + (size_t)seg * SZ3;
        const int row0 = u.pm * BM + wr * 64 + fr, col0 = (u.pn & 7) * 256 + wc * 32 + 8 * fq;
#pragma unroll
        for (int ai = 0; ai < 2; ++ai)
#pragma unroll
            for (int m = 0; m < 4; ++m) { bf16_t* rowp = base + (size_t)(row0 + ai * HALF + m * 16) * 2048 + col0;
#pragma unroll
                for (int bj = 0; bj < 2; ++bj) { f32x4 v0 = acc[ai][bj][m][0], v1 = acc[ai][bj][m][1];
                    if (seg == 0) {
#pragma unroll
                        for (int j = 0; j < 4; ++j) { v0[j] = v0[j] * sigm(v0[j]); v1[j] = v1[j] * sigm(v1[j]); } }
                    u32x4 w; w.x = cvt_pk_bf16(v0[0], v0[1]); w.y = cvt_pk_bf16(v0[2], v0[3]); w.z = cvt_pk_bf16(v1[0], v1[1]); w.w = cvt_pk_bf16(v1[2], v1[3]);
                    *(u32x4*)(rowp + bj * HALF) = w; } }
    }
};
struct EpiInProj8 {
    static constexpr bool PERM = true, AFTER_DRAIN = false;
    bf16_t* P; const PG8_LAS float* scs;
    __device__ __forceinline__ void operator()(const f32x4 (&acc)[2][2][4][2], const Unit& u, int wr, int wc, int fr, int fq) const {
        const int row0 = u.pm * BM + wr * 64 + fr, cl0 = wc * 32 + 8 * fq; const PG8_LAS float* sa = scs + wr * 64 + fr - row0;
        f32x4 sbv[2][2];
#pragma unroll
        for (int bj = 0; bj < 2; ++bj) { sbv[bj][0] = *(const PG8_LAS f32x4*)(scs + 256 + cl0 + bj * HALF); sbv[bj][1] = *(const PG8_LAS f32x4*)(scs + 256 + cl0 + bj * HALF + 4); }
        if (u.pn >= 32 && u.pn < 64) {
            unsigned long long* G8 = (unsigned long long*)(P + 4 * SZ4 + 3 * SZ3) + ((size_t)(((u.pn - 32) >> 4) * 64 + u.pm) * 16 + ((u.pn - 32) & 15)) * 16 * 512 + threadIdx.x;
#pragma unroll
            for (int ai = 0; ai < 2; ++ai)
#pragma unroll
                for (int m = 0; m < 4; ++m) { const float nsr = sa[row0 + ai * HALF + m * 16] * -1.4426950408889634f;
#pragma unroll
                    for (int bj = 0; bj < 2; ++bj) { const v4i32 i0 = __builtin_bit_cast(v4i32, acc[ai][bj][m][0]), i1 = __builtin_bit_cast(v4i32, acc[ai][bj][m][1]); unsigned lo = 0u, hi = 0u;
#pragma unroll
                        for (int j = 0; j < 4; ++j) {
                            const float e0 = __builtin_amdgcn_exp2f((float)i0[j] * (nsr * sbv[bj][0][j])), e1 = __builtin_amdgcn_exp2f((float)i1[j] * (nsr * sbv[bj][1][j]));
                            const float r0 = __builtin_rintf(fmaxf(__builtin_amdgcn_rcpf(e0 * (1.0f / 255.0f) + (1.0f / 255.0f)), 1.0f)), r1 = __builtin_rintf(fmaxf(__builtin_amdgcn_rcpf(e1 * (1.0f / 255.0f) + (1.0f / 255.0f)), 1.0f));
                            lo = __builtin_amdgcn_cvt_pk_u8_f32(r0, j, lo); hi = __builtin_amdgcn_cvt_pk_u8_f32(r1, j, hi); }
                        G8[(size_t)(ai * 8 + m * 2 + bj) * 512] = ((unsigned long long)hi << 32) | lo; } }
            return; }
        const int seg = u.pn >> 3; bf16_t* base = seg < 4 ? P + (size_t)seg * SZ4 : P + 4 * SZ4 + (size_t)(seg == 8 ? 0 : (seg == 9 ? 2 : 1)) * SZ3;
        const int col0 = (u.pn & 7) * 256 + cl0;
#pragma unroll
        for (int ai = 0; ai < 2; ++ai)
#pragma unroll
            for (int m = 0; m < 4; ++m) { const int rr = row0 + ai * HALF + m * 16; const float sr = sa[rr]; bf16_t* rowp = base + (size_t)rr * 2048 + col0;
#pragma unroll
                for (int bj = 0; bj < 2; ++bj) { const v4i32 i0 = __builtin_bit_cast(v4i32, acc[ai][bj][m][0]), i1 = __builtin_bit_cast(v4i32, acc[ai][bj][m][1]); float v[8];
#pragma unroll
                    for (int j = 0; j < 4; ++j) { v[j] = (float)i0[j] * (sr * sbv[bj][0][j]); v[4 + j] = (float)i1[j] * (sr * sbv[bj][1][j]); }
                    if (seg == 0 || seg == 8) { const float scq = seg == 0 ? 0.08838834764831845f : 1.0f;
#pragma unroll
                        for (int j = 0; j < 8; ++j) v[j] = v[j] * sigm(v[j]) * scq; }
                    u32x4 w; w.x = cvt_pk_bf16(v[0], v[1]); w.y = cvt_pk_bf16(v[2], v[3]); w.z = cvt_pk_bf16(v[4], v[5]); w.w = cvt_pk_bf16(v[6], v[7]);
                    *(u32x4*)(rowp + bj * HALF) = w; } }
    }
};
__device__ __forceinline__ void gate8(unsigned long long w, float (&g)[8]) { const unsigned lo = (unsigned)w, hi = (unsigned)(w >> 32);
    g[0] = (float)(lo & 255u); g[1] = (float)((lo >> 8) & 255u); g[2] = (float)((lo >> 16) & 255u); g[3] = (float)(lo >> 24); g[4] = (float)(hi & 255u); g[5] = (float)((hi >> 8) & 255u); g[6] = (float)((hi >> 16) & 255u); g[7] = (float)(hi >> 24);
#pragma unroll
    for (int j = 0; j < 8; ++j) g[j] *= (1.0f / 255.0f); }
__device__ __forceinline__ const char* gate_tile(const bf16_t* Pg, int gate, const Unit& u) { return (const char*)Pg + ((size_t)(gate * 64 + u.pm) * 16 + u.pn) * (16 * 512 * 8); }
__device__ __forceinline__ unsigned long long gate_ld(const char* tile, int it, unsigned toff) { return *(const __attribute__((address_space(1))) unsigned long long*)(tile + it * 4096 + toff); }
template <bool ADD> struct EpiMerge {
    static constexpr bool PERM = true, AFTER_DRAIN = false;
    const bf16_t* Pg; int gate; bf16_t* O;
    __device__ __forceinline__ void operator()(const f32x4 (&acc)[2][2][4][2], const Unit& u, int wr, int wc, int fr, int fq) const {
        const int row0 = u.pm * BM + wr * 64 + fr, col0 = u.pn * BM + wc * 32 + 8 * fq;
        const char* G8 = gate_tile(Pg, gate, u); const unsigned toff = threadIdx.x * 8u;
        u32x4 gq[8];
#pragma unroll
        for (int it = 0; it < 8; ++it) { const unsigned long long a_ = gate_ld(G8, 2 * it, toff), b_ = gate_ld(G8, 2 * it + 1, toff); gq[it] = (u32x4){(unsigned)a_, (unsigned)(a_ >> 32), (unsigned)b_, (unsigned)(b_ >> 32)}; }
        asm volatile("" : "+v"(gq[0]), "+v"(gq[1]), "+v"(gq[2]), "+v"(gq[3]), "+v"(gq[4]), "+v"(gq[5]), "+v"(gq[6]), "+v"(gq[7]));
#pragma unroll
        for (int ai = 0; ai < 2; ++ai)
#pragma unroll
            for (int m = 0; m < 4; ++m) { const int rr = row0 + ai * HALF + m * 16;
#pragma unroll
                for (int bj = 0; bj < 2; ++bj) { const f32x4 v0 = acc[ai][bj][m][0], v1 = acc[ai][bj][m][1];
                    bf16_t* const op = O + tl_off(rr, col0 + bj * HALF, 4096);
                    float g[8]; { const u32x4 q_ = gq[(ai * 8 + m * 2 + bj) >> 1]; gate8(bj ? (((unsigned long long)q_.w << 32) | q_.z) : (((unsigned long long)q_.y << 32) | q_.x), g); }
                    float o[8] = {g[0] * v0[0], g[1] * v0[1], g[2] * v0[2], g[3] * v0[3], g[4] * v1[0], g[5] * v1[1], g[6] * v1[2], g[7] * v1[3]};
                    if (ADD) { const u32x4 p = *(const u32x4*)op;
                        o[0] += bflo(p.x); o[1] += bfhi(p.x); o[2] += bflo(p.y); o[3] += bfhi(p.y); o[4] += bflo(p.z); o[5] += bfhi(p.z); o[6] += bflo(p.w); o[7] += bfhi(p.w); }
                    u32x4 w; w.x = cvt_pk_bf16(o[0], o[1]); w.y = cvt_pk_bf16(o[2], o[3]); w.z = cvt_pk_bf16(o[4], o[5]); w.w = cvt_pk_bf16(o[6], o[7]);
                    *(u32x4*)op = w; } }
    }
};
struct NoMid { static constexpr bool ACTIVE = false; __device__ __forceinline__ void operator()(f32x4 (&)[2][2][4][2], const Unit&, int, int, int, int) const {} };
struct MidScales {
    static constexpr bool ACTIVE = true;
    const float* sa; const float* sb; PG8_LAS unsigned char* scs;
    __device__ __forceinline__ void operator()(f32x4 (&)[2][2][4][2], const Unit& u, int wr, int wc, int fr, int fq) const {
        const int wid = wr * 4 + wc, lane = fq * 16 + fr;
        const float* g = wid < 4 ? sa + (size_t)u.pm * BM + wid * 64 + lane : sb + (size_t)u.pn * BM + (wid - 4) * 64 + lane;
        __builtin_amdgcn_global_load_lds((const unsigned*)g, (PG8_LAS unsigned*)(scs + wid * 256), 4, 0, 0);
    }
};
struct MidRatio {
    static constexpr bool ACTIVE = true;
    const bf16_t* Pg;
    __device__ __forceinline__ void operator()(f32x4 (&acc)[2][2][4][2], const Unit& u, int wr, int wc, int fr, int fq) const {
        unsigned toff = threadIdx.x * 8u; asm volatile("" : "+v"(toff));
        const char* GA = gate_tile(Pg, 0, u); const char* GB = gate_tile(Pg, 1, u); asm volatile("" : "+s"(GA), "+s"(GB));
        u32x4 gw[16];
#pragma unroll
        for (int it = 0; it < 16; ++it) { const unsigned long long a_ = gate_ld(GA, it, toff), b_ = gate_ld(GB, it, toff); gw[it] = (u32x4){(unsigned)a_, (unsigned)(a_ >> 32), (unsigned)b_, (unsigned)(b_ >> 32)}; }
        asm volatile("" : "+v"(gw[0]), "+v"(gw[1]), "+v"(gw[2]), "+v"(gw[3]), "+v"(gw[4]), "+v"(gw[5]), "+v"(gw[6]), "+v"(gw[7]), "+v"(gw[8]), "+v"(gw[9]), "+v"(gw[10]), "+v"(gw[11]), "+v"(gw[12]), "+v"(gw[13]), "+v"(gw[14]), "+v"(gw[15]));
#pragma unroll
        for (int ai = 0; ai < 2; ++ai)
#pragma unroll
            for (int m = 0; m < 4; ++m)
#pragma unroll
                for (int bj = 0; bj < 2; ++bj) { float a[8], b[8]; { const u32x4 g_ = gw[ai * 8 + m * 2 + bj]; gate8(((unsigned long long)g_.y << 32) | g_.x, a); gate8(((unsigned long long)g_.w << 32) | g_.z, b); }
                    f32x4& v0 = acc[ai][bj][m][0]; f32x4& v1 = acc[ai][bj][m][1];
                    v0[0] *= a[0] * __builtin_amdgcn_rcpf(b[0]); v0[1] *= a[1] * __builtin_amdgcn_rcpf(b[1]); v0[2] *= a[2] * __builtin_amdgcn_rcpf(b[2]); v0[3] *= a[3] * __builtin_amdgcn_rcpf(b[3]);
                    v1[0] *= a[4] * __builtin_amdgcn_rcpf(b[4]); v1[1] *= a[5] * __builtin_amdgcn_rcpf(b[5]); v1[2] *= a[6] * __builtin_amdgcn_rcpf(b[6]); v1[3] *= a[7] * __builtin_amdgcn_rcpf(b[7]); }
    }
};
template <int MODE> struct EpiResid {
    static constexpr bool PERM = false, AFTER_DRAIN = false;
    const float* X; const float* mod; float alpha; float* Xo; const float* E; const float* st; const float* g; const float* bb;
    __device__ __forceinline__ void operator()(const f32x4 (&acc)[2][2][4][2], const Unit& u, int wr, int wc, int fr, int fq) const {
        const int row0 = u.pm * BM + wr * 64 + fr, col0 = u.pn * BM + wc * 32 + 4 * fq;
        const float* mrow = mod + (size_t)(u.pm >> 4) * 24576 + col0;
        f32x4 mv[2][2], gv[2][2], bv[2][2];
#pragma unroll
        for (int bj = 0; bj < 2; ++bj)
#pragma unroll
            for (int n = 0; n < 2; ++n) { mv[bj][n] = *(const f32x4*)(mrow + bj * HALF + n * 16);
                if (MODE == 2) { gv[bj][n] = *(const f32x4*)(g + col0 + bj * HALF + n * 16); bv[bj][n] = *(const f32x4*)(bb + col0 + bj * HALF + n * 16); } }
#pragma unroll
        for (int ai = 0; ai < 2; ++ai)
#pragma unroll
            for (int mp = 0; mp < 2; ++mp) {
                f32x4 xv[2][2][2], ev[2][2][2]; float mu[2] = {0.f, 0.f}, rs[2] = {1.f, 1.f};
#pragma unroll
                for (int mm = 0; mm < 2; ++mm) { const int rr = row0 + ai * HALF + (2 * mp + mm) * 16; const float* rowp = X + (size_t)rr * 4096 + col0;
                    const float* erow = nullptr;
                    if (MODE == 1) { const int t = rr & 4095; erow = E + (size_t)((u.pn < 8) ? (t >> 6) : (t & 63)) * 2048 + (col0 & 2047); }
                    if (MODE == 2) { mu[mm] = st[2 * rr]; rs[mm] = st[2 * rr + 1]; }
#pragma unroll
                    for (int bj = 0; bj < 2; ++bj)
#pragma unroll
                        for (int n = 0; n < 2; ++n) { xv[mm][bj][n] = *(const f32x4*)(rowp + bj * HALF + n * 16); if (MODE == 1) ev[mm][bj][n] = *(const f32x4*)(erow + bj * HALF + n * 16); } }
                asm volatile("" : "+v"(xv[0][0][0]), "+v"(xv[0][0][1]), "+v"(xv[0][1][0]), "+v"(xv[0][1][1]), "+v"(xv[1][0][0]), "+v"(xv[1][0][1]), "+v"(xv[1][1][0]), "+v"(xv[1][1][1]));
                if (MODE == 1) asm volatile("" : "+v"(ev[0][0][0]), "+v"(ev[0][0][1]), "+v"(ev[0][1][0]), "+v"(ev[0][1][1]), "+v"(ev[1][0][0]), "+v"(ev[1][0][1]), "+v"(ev[1][1][0]), "+v"(ev[1][1][1]));
                if (MODE == 2) asm volatile("" : "+v"(mu[0]), "+v"(mu[1]), "+v"(rs[0]), "+v"(rs[1]));
#pragma unroll
                for (int mm = 0; mm < 2; ++mm) { const int m = 2 * mp + mm; const int rr = row0 + ai * HALF + m * 16; float* rowo = Xo + (size_t)rr * 4096 + col0;
#pragma unroll
                    for (int bj = 0; bj < 2; ++bj)
#pragma unroll
                        for (int n = 0; n < 2; ++n) { f32x4 x_ = xv[mm][bj][n];
                            if (MODE == 1) x_ += ev[mm][bj][n];
                            if (MODE == 2) x_ = (x_ - mu[mm]) * rs[mm] * gv[bj][n] + bv[bj][n];
                            *(f32x4*)(rowo + bj * HALF + n * 16) = x_ * alpha + mv[bj][n] * acc[ai][bj][m][n]; } } }
    }
};
struct MidLn {
    static constexpr bool ACTIVE = true;
    const float* mod; const float* g; const float* bb; const float* st; PG8_LAS unsigned char* slot;
    __device__ __forceinline__ void operator()(f32x4 (&)[2][2][4][2], const Unit& u, int wr, int wc, int fr, int fq) const {
        const int wid = wr * 4 + wc, lane = fq * 16 + fr;
        if (wid < 5) { const float* src = wid == 0 ? mod + (size_t)(u.pm >> 4) * 24576 + u.pn * BM : (wid == 1 ? g + u.pn * BM : (wid == 2 ? bb + u.pn * BM : st + (size_t)u.pm * BM * 2 + (wid - 3) * 256));
            __builtin_amdgcn_global_load_lds((const unsigned*)(src + lane * 4), (PG8_LAS unsigned*)(slot + wid * 1024), 16, 0, 0); }
    }
};
struct EpiResidLn {
    static constexpr bool PERM = false, AFTER_DRAIN = false;
    const float* X; float alpha; float* Xo; const PG8_LAS float* slot;
    __device__ __forceinline__ void operator()(const f32x4 (&acc)[2][2][4][2], const Unit& u, int wr, int wc, int fr, int fq) const {
        const int row0 = u.pm * BM + wr * 64 + fr, col0 = u.pn * BM + wc * 32 + 4 * fq;
#pragma unroll
        for (int ai = 0; ai < 2; ++ai) {
            f32x4 xv[4][2][2];
#pragma unroll
            for (int m = 0; m < 4; ++m) { const float* rowp = X + (size_t)(row0 + ai * HALF + m * 16) * 4096 + col0;
#pragma unroll
                for (int bj = 0; bj < 2; ++bj)
#pragma unroll
                    for (int n = 0; n < 2; ++n) xv[m][bj][n] = *(const f32x4*)(rowp + bj * HALF + n * 16); }
            asm volatile("" : "+v"(xv[0][0][0]), "+v"(xv[0][0][1]), "+v"(xv[0][1][0]), "+v"(xv[0][1][1]), "+v"(xv[1][0][0]), "+v"(xv[1][0][1]), "+v"(xv[1][1][0]), "+v"(xv[1][1][1]),
                              "+v"(xv[2][0][0]), "+v"(xv[2][0][1]), "+v"(xv[2][1][0]), "+v"(xv[2][1][1]), "+v"(xv[3][0][0]), "+v"(xv[3][0][1]), "+v"(xv[3][1][0]), "+v"(xv[3][1][1]));
#pragma unroll
            for (int m = 0; m < 4; ++m) { int lcol = wc * 32 + 4 * fq, lrow = wr * 64 + fr + ai * HALF + m * 16; asm volatile("" : "+v"(lcol), "+v"(lrow));
                float* rowo = Xo + (size_t)(row0 + ai * HALF + m * 16) * 4096 + col0;
                const float mu = slot[768 + 2 * lrow], rs = slot[768 + 2 * lrow + 1];
#pragma unroll
                for (int bj = 0; bj < 2; ++bj)
#pragma unroll
                    for (int n = 0; n < 2; ++n) { const int c = lcol + bj * HALF + n * 16;
                        const f32x4 mv = *(const PG8_LAS f32x4*)(slot + c), gv = *(const PG8_LAS f32x4*)(slot + 256 + c), bv = *(const PG8_LAS f32x4*)(slot + 512 + c);
                        const f32x4 x_ = (xv[m][bj][n] - mu) * rs * gv + bv;
                        *(f32x4*)(rowo + bj * HALF + n * 16) = x_ * alpha + mv * acc[ai][bj][m][n]; } } }
    }
};
struct EpiRelu2 {
    static constexpr bool PERM = true, AFTER_DRAIN = false;
    bf16_t* O; int ldc;
    __device__ __forceinline__ void operator()(const f32x4 (&acc)[2][2][4][2], const Unit& u, int wr, int wc, int fr, int fq) const {
        const int row0 = u.pm * BM + wr * 64 + fr, col0 = u.pn * BM + wc * 32 + 8 * fq;
#pragma unroll
        for (int ai = 0; ai < 2; ++ai)
#pragma unroll
            for (int m = 0; m < 4; ++m) { const int rr = row0 + ai * HALF + m * 16;
#pragma unroll
                for (int bj = 0; bj < 2; ++bj) { f32x4 v0 = acc[ai][bj][m][0], v1 = acc[ai][bj][m][1];
                    bf16_t* const rowp = O + tl_off(rr, col0, ldc) - bj * HALF + (size_t)bj * 2 * 16384;
#pragma unroll
                    for (int j = 0; j < 4; ++j) { const float a = fmaxf(v0[j], 0.f), b = fmaxf(v1[j], 0.f); v0[j] = a * a; v1[j] = b * b; }
                    u32x4 w; w.x = cvt_pk_bf16(v0[0], v0[1]); w.y = cvt_pk_bf16(v0[2], v0[3]); w.z = cvt_pk_bf16(v1[0], v1[1]); w.w = cvt_pk_bf16(v1[2], v1[3]);
                    *(u32x4*)(rowp + bj * HALF) = w; } }
    }
};

struct EpiRelu2Q {
    static constexpr bool PERM = true, AFTER_DRAIN = false;
    bf16_t* O; int ldc; const PG8_LAS float* scs;
    __device__ __forceinline__ void operator()(const f32x4 (&acc)[2][2][4][2], const Unit& u, int wr, int wc, int fr, int fq) const {
        const int row0 = u.pm * BM + wr * 64 + fr, col0 = u.pn * BM + wc * 32 + 8 * fq; const PG8_LAS float* sa = scs + wr * 64 + fr - row0;
        f32x4 sbv[2][2];
#pragma unroll
        for (int bj = 0; bj < 2; ++bj) { sbv[bj][0] = *(const PG8_LAS f32x4*)(scs + 256 + wc * 32 + 8 * fq + bj * HALF); sbv[bj][1] = *(const PG8_LAS f32x4*)(scs + 256 + wc * 32 + 8 * fq + bj * HALF + 4); }
#pragma unroll
        for (int ai = 0; ai < 2; ++ai)
#pragma unroll
            for (int m = 0; m < 4; ++m) { const int rr = row0 + ai * HALF + m * 16; const float sr = sa[rr];
#pragma unroll
                for (int bj = 0; bj < 2; ++bj) { const v4i32 i0 = __builtin_bit_cast(v4i32, acc[ai][bj][m][0]), i1 = __builtin_bit_cast(v4i32, acc[ai][bj][m][1]);
                    bf16_t* const rowp = O + tl_off(rr, col0, ldc) + (size_t)bj * 2 * 16384;
                    float v[8];
#pragma unroll
                    for (int j = 0; j < 4; ++j) { const float a = fmaxf((float)i0[j] * (sr * sbv[bj][0][j]), 0.f), b = fmaxf((float)i1[j] * (sr * sbv[bj][1][j]), 0.f); v[j] = a * a; v[4 + j] = b * b; }
                    u32x4 w; w.x = cvt_pk_bf16(v[0], v[1]); w.y = cvt_pk_bf16(v[2], v[3]); w.z = cvt_pk_bf16(v[4], v[5]); w.w = cvt_pk_bf16(v[6], v[7]);
                    *(u32x4*)rowp = w; } }
    }
};

typedef int v8i32 __attribute__((ext_vector_type(8)));
template <class Epi, class Sched, bool ALIGN_EPI = false, bool SP2 = false, class Mid = NoMid, int FMT = 0>
__device__ __forceinline__ void gemm_phase(PG8_LAS unsigned char* lds, const Gemm g, const Sched& S, const Epi& E, const Mid& MH = Mid()) {
    constexpr bool FP8 = (FMT == 1), INT8 = (FMT == 2);
    const int tid = threadIdx.x, wid = __builtin_amdgcn_readfirstlane(tid >> 6), lane = tid & 63, wr = wid >> 2, wc = wid & 3, fr = lane & 15, fq = lane >> 4;
    const int K = g.K, nt = K / BK;
    unsigned voffA[2], voffB[2];
#pragma unroll
    for (int i = 0; i < 2; ++i) { int R, C; stage_rc(tid * 16 + i * 8192, R, C); const int Rb = Epi::PERM ? ((R & ~31) + perm32(R & 31)) : R;
        (void)R; (void)C; (void)Rb; voffA[i] = (unsigned)(tid * 16 + i * 8192); voffB[i] = voffA[i]; }
    const size_t kstepA = g.A.kstep, kstepB = g.B.kstep;
    const size_t hstepA = g.A.hstep, hstepB = g.B.hstep;
    const size_t tstepA = g.A.tstep, tstepB = g.B.tstep;
    const unsigned ldsw = (unsigned)wid * 1024u;
    const int aoff = lds_byte(wr * 64 + fr, fq * 8), boff = lds_byte(wc * 32 + fr, fq * 8);
#define PG8_SA(b, h) (((b) * 2 + (h)) * HTB)
#define PG8_SB(b, h) ((4 + (b) * 2 + (h)) * HTB)
#define PG8_STAGE(bufoff, gbase, voff) do { _Pragma("unroll") for (int _i = 0; _i < 2; ++_i) \
        __builtin_amdgcn_global_load_lds((const unsigned*)((const char*)(gbase) + (voff)[_i]), (PG8_LAS unsigned*)(lds + (bufoff) + ldsw + _i * 8192), 16, 0, PG8_AUX); } while (0)
#define PG8_LDA(dst, b, h) do { _Pragma("unroll") for (int m = 0; m < 4; ++m) _Pragma("unroll") for (int k = 0; k < 2; ++k) dst[m][k] = *(const PG8_LAS bf16x8*)(lds + PG8_SA(b, h) + aoff + m * 2048 + k * 1024); } while (0)
#define PG8_LDB(dst, b, h) do { _Pragma("unroll") for (int n = 0; n < 2; ++n) _Pragma("unroll") for (int k = 0; k < 2; ++k) dst[n][k] = *(const PG8_LAS bf16x8*)(lds + PG8_SB(b, h) + boff + n * 2048 + k * 1024); } while (0)
#define PG8_MMA(ai, bj, At, Bt) do { __builtin_amdgcn_s_setprio(1); if constexpr (FP8) { _Pragma("unroll") for (int m = 0; m < 4; ++m) _Pragma("unroll") for (int n = 0; n < 2; ++n) \
        asm volatile("v_mfma_scale_f32_16x16x128_f8f6f4 %0, %1, %2, %0, %3, %4 op_sel_hi:[0,0,0]" : "+v"(acc[ai][bj][m][n]) \
            : "v"(__builtin_bit_cast(v8i32, __builtin_shufflevector(Bt[n][0], Bt[n][1], 0, 1, 2, 3, 4, 5, 6, 7, 8, 9, 10, 11, 12, 13, 14, 15))), \
              "v"(__builtin_bit_cast(v8i32, __builtin_shufflevector(At[m][0], At[m][1], 0, 1, 2, 3, 4, 5, 6, 7, 8, 9, 10, 11, 12, 13, 14, 15))), "v"(0x79797979), "v"(0x7f7f7f7f)); } else if constexpr (INT8) { \
        _Pragma("unroll") for (int m = 0; m < 4; ++m) _Pragma("unroll") for (int n = 0; n < 2; ++n) _Pragma("unroll") for (int k = 0; k < 2; ++k) \
        acc[ai][bj][m][n] = __builtin_bit_cast(f32x4, __builtin_amdgcn_mfma_i32_16x16x64_i8(__builtin_bit_cast(v4i32, Bt[n][k]), __builtin_bit_cast(v4i32, At[m][k]), __builtin_bit_cast(v4i32, acc[ai][bj][m][n]), 0, 0, 0)); } else { \
        _Pragma("unroll") for (int m = 0; m < 4; ++m) _Pragma("unroll") for (int n = 0; n < 2; ++n) _Pragma("unroll") for (int k = 0; k < 2; ++k) \
        acc[ai][bj][m][n] = __builtin_amdgcn_mfma_f32_16x16x32_bf16(Bt[n][k], At[m][k], acc[ai][bj][m][n], 0, 0, 0); } __builtin_amdgcn_s_setprio(0); } while (0)
#define PG8_WAIT_V(n) asm volatile("s_waitcnt vmcnt(" #n ")" ::: "memory")
#define PG8_WAIT_L(n) asm volatile("s_waitcnt lgkmcnt(" #n ")" ::: "memory")
#define PG8_BAR __builtin_amdgcn_s_barrier()
#define PG8_SCHED __builtin_amdgcn_sched_barrier(0)
    Unit cur, nxt; int ui = 0;
    if (!S.next(0, cur)) return;
    f32x4 acc[2][2][4][2];
#pragma unroll
    for (int a = 0; a < 2; ++a)
#pragma unroll
        for (int b = 0; b < 2; ++b)
#pragma unroll
            for (int m = 0; m < 4; ++m)
#pragma unroll
                for (int n = 0; n < 2; ++n) acc[a][b][m][n] = (f32x4){0.f, 0.f, 0.f, 0.f};
    bf16x8 At[4][2], B0[2][2], B1[2][2];
    const char* cA = (const char*)g.A.p + (size_t)cur.pm * tstepA; const char* cB = (const char*)g.B.p + (size_t)cur.pn * tstepB;
    S.a_ready(cur);
    if constexpr (SP2) {
        PG8_STAGE(PG8_SB(0, 0), cB, voffB); PG8_STAGE(PG8_SB(0, 1), cB + hstepB, voffB); PG8_STAGE(PG8_SA(0, 0), cA, voffA); PG8_STAGE(PG8_SA(0, 1), cA + hstepA, voffA);
        if (wr == 1) PG8_BAR;
        PG8_WAIT_V(2); PG8_BAR;
        PG8_STAGE(PG8_SB(1, 0), cB + kstepB, voffB); PG8_STAGE(PG8_SA(1, 0), cA + kstepA, voffA); PG8_STAGE(PG8_SB(1, 1), cB + hstepB + kstepB, voffB);
        PG8_WAIT_V(6); PG8_BAR;
    } else {
        PG8_STAGE(PG8_SB(0, 0), cB, voffB); PG8_STAGE(PG8_SA(0, 0), cA, voffA); PG8_STAGE(PG8_SB(0, 1), cB + hstepB, voffB); PG8_STAGE(PG8_SA(0, 1), cA + hstepA, voffA);
        if (wr == 1) PG8_BAR;
        PG8_WAIT_V(4); PG8_BAR;
        PG8_STAGE(PG8_SB(1, 0), cB + kstepB, voffB); PG8_STAGE(PG8_SA(1, 0), cA + kstepA, voffA); PG8_STAGE(PG8_SB(1, 1), cB + hstepB + kstepB, voffB);
        PG8_WAIT_V(6); PG8_BAR;
    }
    for (;;) {
        const bool has_next = S.next(ui + 1, nxt);
        const char* nA = has_next ? (const char*)g.A.p + (size_t)nxt.pm * tstepA : cA; const char* nB = has_next ? (const char*)g.B.p + (size_t)nxt.pn * tstepB : cB;
        for (int t = 0; t < nt; t += 2) {
            const bool last = (t == nt - 2);
            const char* a1 = cA + (size_t)(t + 1) * kstepA;
            const char* a2 = last ? nA : cA + (size_t)(t + 2) * kstepA; const char* b2 = last ? nB : cB + (size_t)(t + 2) * kstepB;
            const char* a3 = a2 + kstepA; const char* b3 = b2 + kstepB;
            if (last && has_next) S.a_ready(nxt);
            if constexpr (Mid::ACTIVE) { if (t == (nt >> 1)) MH(acc, cur, wr, wc, fr, fq); }
            if constexpr (SP2) {
            PG8_LDB(B0, 0, 0); PG8_LDB(B1, 0, 1); PG8_SCHED; PG8_LDA(At, 0, 0); PG8_STAGE(PG8_SA(1, 1), a1 + hstepA, voffA);
            PG8_WAIT_V(8); PG8_WAIT_L(0); PG8_BAR; PG8_MMA(0, 0, At, B0); PG8_MMA(0, 1, At, B1); PG8_BAR; PG8_SCHED;
            PG8_LDA(At, 0, 1); PG8_STAGE(PG8_SB(0, 0), b2, voffB); PG8_STAGE(PG8_SB(0, 1), b2 + hstepB, voffB); PG8_STAGE(PG8_SA(0, 0), a2, voffA);
            PG8_WAIT_V(8); PG8_WAIT_L(0); PG8_BAR; PG8_MMA(1, 0, At, B0); PG8_MMA(1, 1, At, B1); PG8_BAR; PG8_SCHED;
            PG8_LDB(B0, 1, 0); PG8_LDB(B1, 1, 1); PG8_SCHED; PG8_LDA(At, 1, 0); PG8_STAGE(PG8_SA(0, 1), a2 + hstepA, voffA);
            PG8_WAIT_V(8); PG8_WAIT_L(0); PG8_BAR; PG8_MMA(0, 0, At, B0); PG8_MMA(0, 1, At, B1); PG8_BAR; PG8_SCHED;
            PG8_LDA(At, 1, 1); PG8_STAGE(PG8_SB(1, 0), b3, voffB); PG8_STAGE(PG8_SB(1, 1), b3 + hstepB, voffB); PG8_STAGE(PG8_SA(1, 0), a3, voffA);
            PG8_WAIT_V(8); PG8_WAIT_L(0); PG8_BAR; PG8_MMA(1, 0, At, B0); PG8_MMA(1, 1, At, B1); PG8_BAR; PG8_SCHED;
            } else {
            PG8_LDB(B0, 0, 0); PG8_SCHED; PG8_LDA(At, 0, 0); PG8_STAGE(PG8_SA(1, 1), a1 + hstepA, voffA);
            PG8_WAIT_L(8); PG8_BAR; PG8_WAIT_L(0); PG8_MMA(0, 0, At, B0); PG8_BAR; PG8_SCHED;
            PG8_LDB(B1, 0, 1); PG8_STAGE(PG8_SB(0, 0), b2, voffB);
            PG8_BAR; PG8_WAIT_L(0); PG8_MMA(0, 1, At, B1); PG8_BAR;
            PG8_LDA(At, 0, 1); PG8_STAGE(PG8_SA(0, 0), a2, voffA);
            PG8_BAR; PG8_WAIT_L(0); PG8_MMA(1, 0, At, B0); PG8_BAR; PG8_SCHED;
            PG8_STAGE(PG8_SB(0, 1), b2 + hstepB, voffB);
            PG8_WAIT_V(6); PG8_BAR; PG8_MMA(1, 1, At, B1); PG8_BAR;
            PG8_LDB(B0, 1, 0); PG8_SCHED; PG8_LDA(At, 1, 0); PG8_STAGE(PG8_SA(0, 1), a2 + hstepA, voffA);
            PG8_WAIT_L(8); PG8_BAR; PG8_WAIT_L(0); PG8_MMA(0, 0, At, B0); PG8_BAR; PG8_SCHED;
            PG8_LDB(B1, 1, 1); PG8_STAGE(PG8_SB(1, 0), b3, voffB);
            PG8_BAR; PG8_WAIT_L(0); PG8_MMA(0, 1, At, B1); PG8_BAR;
            PG8_LDA(At, 1, 1); PG8_STAGE(PG8_SA(1, 0), a3, voffA);
            PG8_BAR; PG8_WAIT_L(0); PG8_MMA(1, 0, At, B0); PG8_BAR; PG8_SCHED;
            PG8_STAGE(PG8_SB(1, 1), b3 + hstepB, voffB);
            PG8_WAIT_V(6); PG8_BAR; PG8_MMA(1, 1, At, B1); PG8_BAR;
            }
        }
        if constexpr (ALIGN_EPI) { if (wr == 0) PG8_BAR; }
        if constexpr (FP8) asm volatile("s_nop 15\n\ts_nop 15" ::: "memory");
        E(acc, cur, wr, wc, fr, fq); S.done(cur);
        if (!has_next) break;
#pragma unroll
        for (int a = 0; a < 2; ++a)
#pragma unroll
            for (int b = 0; b < 2; ++b)
#pragma unroll
                for (int m = 0; m < 4; ++m)
#pragma unroll
                    for (int n = 0; n < 2; ++n) acc[a][b][m][n] = (f32x4){0.f, 0.f, 0.f, 0.f};
        cur = nxt; cA = nA; cB = nB; ++ui;
        if constexpr (ALIGN_EPI) { if (wr == 1) PG8_BAR; }
    }
    PG8_WAIT_V(0);
    if constexpr (!ALIGN_EPI) { if (wr == 0) PG8_BAR; }
    PG8_BAR;
#undef PG8_SA
#undef PG8_SB
#undef PG8_STAGE
#undef PG8_LDA
#undef PG8_LDB
#undef PG8_MMA
#undef PG8_WAIT_V
#undef PG8_WAIT_L
#undef PG8_BAR
#undef PG8_SCHED
}
}

#ifndef PG8_SP2
#define PG8_SP2 true
#endif
#ifndef PG8_ALIGN
#define PG8_ALIGN true
#endif

constexpr int NWAVES = 8;
constexpr int D = 4096, NB = 4, T = 4096, M = NB * T, CTXL = 256, MC = NB * CTXL, MALL = M + MC;
constexpr int AW = 2048, NH = 16, HK = 128, HV = 128, BW = 2048, NG = 16, GC = 128, MIXC = 128, DFF = 16384, NIN = 22528, NMOD = 6;
constexpr float LN_EPS = 1e-6f;
constexpr float ALPHA = 1.189207115002721f;

constexpr size_t MiB = 1u << 20;
constexpr size_t WS_CTL = 0, CTL_ZERO_BYTES = 1 * MiB;
constexpr size_t WS_ETAB = 1 * MiB;
constexpr size_t WS_MODX = 1 * MiB + 512 * 1024;
constexpr size_t WS_MODC = WS_MODX + 4 * 24576 * 4;
constexpr size_t WS_STAT = 2 * MiB;
constexpr size_t WS_ST1 = 2 * MiB + 256 * 1024;
constexpr size_t WS_SA2 = 2 * MiB + 384 * 1024;
constexpr size_t WS_SB1 = 2 * MiB + 448 * 1024;
constexpr size_t WS_LB = 2 * MiB + 512 * 1024;
constexpr size_t WS_SA1 = 2 * MiB + 576 * 1024;
constexpr size_t WS_SB0 = 2 * MiB + 768 * 1024;
constexpr size_t WS_DSUM = 3 * MiB;
constexpr size_t WS_WPAB = 8 * MiB;
constexpr size_t WS_WOUT = 40 * MiB;
constexpr size_t WS_WFF1 = 72 * MiB;
constexpr size_t WS_WFF2 = 200 * MiB;
constexpr size_t WS_OBUF = WS_WFF1;
constexpr size_t WS_WIN = 328 * MiB;
constexpr size_t WS_WIN8 = WS_WIN;
constexpr size_t WS_WINB = WS_WIN + 96 * MiB;
constexpr size_t WS_H8 = 1360 * MiB;
constexpr size_t WS_HBUF = 504 * MiB;
constexpr size_t WS_P = 640 * MiB;
constexpr size_t WS_ABUF = 640 * MiB;
constexpr size_t WS_Y = 1360 * MiB;
constexpr size_t WS_END = 1488 * MiB;
constexpr size_t WS_LBUF = WS_WIN;
static_assert(WS_LBUF + (size_t)8704 * 16384 * 2 <= WS_P, "L region");
static_assert(WS_P + (4 * pg8::SZ4 + 3 * pg8::SZ3 + 2 * pg8::SZG) * 2 <= WS_Y, "p region");
static_assert(WS_HBUF + (size_t)MALL * D * 2 <= WS_P && WS_WIN + (size_t)NIN * D * 2 <= WS_HBUF, "ws map");
constexpr int CW_TMO = 0, CW_BAR = 4096;

constexpr int RING_OFF = 0, RING_BYTES = 131072;
constexpr int LDSCTL_OFF = RING_BYTES, MISC_OFF = LDSCTL_OFF + 320;
constexpr int LDS_BYTES = 147456;

#define GAS __attribute__((address_space(1)))
#define LAS __attribute__((address_space(3)))
typedef unsigned short bf16;
typedef unsigned v4u __attribute__((ext_vector_type(4)));
typedef unsigned v2u __attribute__((ext_vector_type(2)));
typedef float f32x4 __attribute__((ext_vector_type(4)));
typedef GAS unsigned gu32;
#define RLX_AGENT __ATOMIC_RELAXED, __HIP_MEMORY_SCOPE_AGENT
#define LDS_WAIT() asm volatile("s_waitcnt lgkmcnt(0)" ::: "memory")
#define VM_WAIT() asm volatile("s_waitcnt vmcnt(0)" ::: "memory")
__device__ __forceinline__ unsigned f2bf(float f) { unsigned u = __builtin_bit_cast(unsigned, f); return (u + 0x7fffu + ((u >> 16) & 1u)) >> 16; }
typedef float f32x2v_ __attribute__((ext_vector_type(2)));
typedef __bf16 bf16x2v_ __attribute__((ext_vector_type(2)));
__device__ __forceinline__ unsigned pk2(float lo, float hi) { const f32x2v_ v = {lo, hi}; return __builtin_bit_cast(unsigned, __builtin_convertvector(v, bf16x2v_)); }
__device__ __forceinline__ float bf2f(bf16 b) { return __uint_as_float(((unsigned)b) << 16); }
__device__ __forceinline__ int opq(int x) { asm volatile("" : "+v"(x)); return x; }
__device__ __forceinline__ unsigned pack_i8(float a, float b, float c, float d) {
    const int ia = (int)__builtin_rintf(a), ib = (int)__builtin_rintf(b), ic = (int)__builtin_rintf(c), id = (int)__builtin_rintf(d);
    return (unsigned)(ia & 255) | ((unsigned)(ib & 255) << 8) | ((unsigned)(ic & 255) << 16) | ((unsigned)id << 24); }

using pg8::bflo; using pg8::bfhi; using pg8::sigm;

#define XB_TMO      128
#define XB_XCNT(j)  (256  + 64 * (j))
#define XB_XSUB(j)  (1280 + 64 * (j))
#define XB_XGEN(j)  (2304 + 64 * (j))
#define XB_TOP      3328
#define XB_TOPGEN   3392
#define XCD_BAR_WORDS 3456
#define XB_SPIN_CAP (1u << 22)

__device__ __forceinline__ unsigned xb_ld(unsigned* p)              { return __hip_atomic_load(p, __ATOMIC_RELAXED, __HIP_MEMORY_SCOPE_AGENT); }
__device__ __forceinline__ unsigned xb_add(unsigned* p, unsigned v) { return __hip_atomic_fetch_add(p, v, __ATOMIC_RELAXED, __HIP_MEMORY_SCOPE_AGENT); }
__device__ __forceinline__ unsigned xb_xcc_id() { return (unsigned)__builtin_amdgcn_s_getreg((3 << 11) | 20) & 0xFu; }
#define XB_SPIN(cond, bar) do { unsigned _sp = 0; while (cond) { __builtin_amdgcn_s_sleep(1); \
    if ((++_sp & 255u) == 0u) { if (xb_ld(&(bar)[XB_TMO])) break; if (_sp > XB_SPIN_CAP) { atomicAdd(&(bar)[XB_TMO], 1u); break; } } } } while (0)

struct XcdBarrier { unsigned* bar; unsigned x; volatile LAS unsigned* st; };
__device__ __forceinline__ XcdBarrier xcd_barrier_post(unsigned* bar, volatile LAS unsigned* st) {
    XcdBarrier b; b.bar = bar; b.x = xb_xcc_id(); b.st = st;
    if (threadIdx.x == 0) (void)xb_add(&bar[XB_XCNT(b.x)], 1u);
    return b;
}
__device__ __forceinline__ void xcd_barrier_complete(unsigned* bar, unsigned x, unsigned& nloc, unsigned& nx) {
    const unsigned G = gridDim.x * gridDim.y * gridDim.z;
    unsigned sum, cnt, mine, sp = 0u;
    for (;;) {
        sum = 0u; cnt = 0u; mine = 0u;
#pragma unroll
        for (unsigned j = 0; j < 16; ++j) { const unsigned c = xb_ld(&bar[XB_XCNT(j)]); sum += c; cnt += (c > 0u) ? 1u : 0u; mine = (j == x) ? c : mine; }
        if (sum == G) break;
        __builtin_amdgcn_s_sleep(1);
        if ((++sp & 255u) == 0u) { if (xb_ld(&bar[XB_TMO])) break; if (sp > XB_SPIN_CAP) { atomicAdd(&bar[XB_TMO], 1u); break; } }
    }
    nloc = mine > 0u ? mine : 1u; nx = cnt > 0u ? cnt : 1u;
}
__device__ __forceinline__ void xcd_barrier(const XcdBarrier& b) {
    asm volatile("s_waitcnt vmcnt(0)" ::: "memory");
    __syncthreads();
    if (threadIdx.x == 0) {
        unsigned* bar = b.bar;
        __builtin_amdgcn_s_waitcnt(0);
        unsigned nloc = b.st[0], nx = b.st[1];
        if (nloc == 0u) { xcd_barrier_complete(bar, b.x, nloc, nx); b.st[0] = nloc; b.st[1] = nx; }
        const unsigned old = xb_add(&bar[XB_XSUB(b.x)], 1u);
        const unsigned gen = old / nloc;
        if (old + 1u == (gen + 1u) * nloc) {
            __builtin_amdgcn_fence(__ATOMIC_RELEASE, "agent");
            asm volatile("s_waitcnt vmcnt(0)" ::: "memory");
            const unsigned og = xb_add(&bar[XB_TOP], 1u);
            const unsigned tg = og / nx;
            if (og + 1u == (tg + 1u) * nx) xb_add(&bar[XB_TOPGEN], 1u);
            else XB_SPIN(xb_ld(&bar[XB_TOPGEN]) == tg, bar);
            __builtin_amdgcn_fence(__ATOMIC_ACQUIRE, "agent");
            xb_add(&bar[XB_XGEN(b.x)], 1u);
            asm volatile("s_waitcnt vmcnt(0)" ::: "memory");
        } else {
            XB_SPIN(xb_ld(&bar[XB_XGEN(b.x)]) == gen, bar);
            __builtin_amdgcn_fence(__ATOMIC_ACQUIRE, "agent");
            asm volatile("s_waitcnt vmcnt(0)" ::: "memory");
        }
    }
    __syncthreads();
}

struct Frame {
    LAS unsigned char* lds;
    volatile LAS unsigned* MISC;
    gu32* ctl;
    int tid, lane, wave, G;
    const float *x, *c, *ctx, *c_ctx, *w_ada, *b_ada, *w_in, *lbl, *a_norm_g, *w_proj_a, *v_norm_g, *v_norm_b, *w_s, *b_s, *w_proj_b, *w_out, *ln1_g, *ln1_b, *w_ff1, *w_ff2, *ln2_g, *ln2_b;
    float* out; unsigned char* ws;
};
template <int CTRL> __device__ __forceinline__ float dpp_perm(float x) { return __builtin_bit_cast(float, __builtin_amdgcn_update_dpp(0, __builtin_bit_cast(int, x), CTRL, 0xf, 0xf, true)); }
__device__ __forceinline__ float lane_val(float v, int l) { return __builtin_bit_cast(float, __builtin_amdgcn_readlane(__builtin_bit_cast(int, v), l)); }
__device__ __forceinline__ float wave_sum(float v) {
    v += dpp_perm<0xB1>(v); v += dpp_perm<0x4E>(v); v += dpp_perm<0x141>(v); v += dpp_perm<0x140>(v);
    return (lane_val(v, 0) + lane_val(v, 16)) + (lane_val(v, 32) + lane_val(v, 48));
}
__device__ __forceinline__ float wave_max(float v) {
    v = fmaxf(v, dpp_perm<0xB1>(v)); v = fmaxf(v, dpp_perm<0x4E>(v)); v = fmaxf(v, dpp_perm<0x141>(v)); v = fmaxf(v, dpp_perm<0x140>(v));
    return fmaxf(fmaxf(lane_val(v, 0), lane_val(v, 16)), fmaxf(lane_val(v, 32), lane_val(v, 48)));
}

__device__ __forceinline__ float lb_of(const float* lbl, int dir, int ch) { const float l0 = lbl[dir * 4096 + ch], l1 = lbl[dir * 4096 + 2048 + ch]; return 1.0f / (1.0f + expf(l1 - l0)); }
__device__ __forceinline__ void p0_transpose_item(const float* W, int N, bf16* WT, int ldk, int kofs, bool perm, LAS float* scr, int item, int lane) {
    const int nblk = N / 32, kb = item / nblk, nb = item % nblk, k0 = 64 * kb, n0 = 32 * nb;
    { float t[32]; const float* wp = W + (size_t)(k0 + (lane >> 5)) * N + n0 + (lane & 31);
#pragma unroll
      for (int i = 0; i < 32; ++i) t[i] = wp[(size_t)(2 * i) * N];
      LAS float* sw = scr + (lane >> 5) * 33 + (lane & 31);
#pragma unroll
      for (int i = 0; i < 32; ++i) sw[2 * i * 33] = t[i]; }
    LDS_WAIT(); asm volatile("" ::: "memory");
    const int c = lane & 7;
#pragma unroll
    for (int j = 0; j < 4; ++j) { const int n = (lane >> 3) + 8 * j; const LAS float* s = scr + (8 * c) * 33 + n;
        v4u o; o.x = pk2(s[0 * 33], s[1 * 33]); o.y = pk2(s[2 * 33], s[3 * 33]); o.z = pk2(s[4 * 33], s[5 * 33]); o.w = pk2(s[6 * 33], s[7 * 33]);
        *(GAS v4u*)(WT + pg8::tl_off_b(n0 + n, kofs + k0 + 8 * c, ldk, perm)) = o; }
    LDS_WAIT(); asm volatile("" ::: "memory");
}

__device__ __forceinline__ void p0_mod_unit(Frame& F, int unit) {
    LAS float* sl = (LAS float*)(F.lds + RING_OFF);
    LAS float* red = (LAS float*)(F.lds + RING_OFF + 5 * 4096 * 4);
    for (int i = F.tid; i < 5 * 4096; i += NWAVES * 64) { const int r = i >> 12, k = i & 4095; const float v = (r < 4) ? F.c[r * 4096 + k] : F.c_ctx[k]; sl[i] = v * sigm(v); }
    __syncthreads();
    const int col = 128 * unit + 4 * (F.lane & 31), rg = F.wave * 2 + (F.lane >> 5);
    f32x4 a0 = {0.f, 0.f, 0.f, 0.f}, a1 = a0, a2 = a0, a3 = a0, a4 = a0;
    const float* wp = F.w_ada + (size_t)rg * 24576 + col;
    for (int i0 = 0; i0 < 256; i0 += 32) {
        f32x4 wv[32];
#pragma unroll
        for (int i = 0; i < 32; ++i) wv[i] = *(const GAS f32x4*)(wp + (size_t)(i0 + i) * 16 * 24576);
#pragma unroll
        for (int i = 0; i < 32; ++i) { const int k = rg + 16 * (i0 + i); const f32x4 w = wv[i];
            a0 += w * sl[k]; a1 += w * sl[4096 + k]; a2 += w * sl[8192 + k]; a3 += w * sl[12288 + k]; a4 += w * sl[16384 + k]; } }
    LAS f32x4* r4 = (LAS f32x4*)red + (rg * 5) * 32 + (F.lane & 31);
    r4[0] = a0; r4[32] = a1; r4[64] = a2; r4[96] = a3; r4[128] = a4;
    __syncthreads();
    for (int i = F.tid; i < 5 * 128; i += NWAVES * 64) { const int r = i >> 7, cc = i & 127; float s = 0.f;
#pragma unroll
        for (int g = 0; g < 16; ++g) s += red[(g * 5 + r) * 128 + cc];
        const int gc = 128 * unit + cc; s += F.b_ada[gc];
        if (r < 4) ((float*)(F.ws + WS_MODX))[r * 24576 + gc] = s; else ((float*)(F.ws + WS_MODC))[gc] = s; }
    __syncthreads();
}

template <class NSrc> __device__ __forceinline__ void quant_cols(Frame& F, const float* W, int N, int nblocks, unsigned char* W8, float* sb, NSrc nsrc) {
    LAS float* scr = (LAS float*)(F.lds + RING_OFF + F.wave * 16384);
    LAS float* cmax = (LAS float*)(F.lds + RING_OFF + 8 * 16384 - 2048);
    LAS float* cinv = cmax + 256;
    const int kq = F.wave, lane = F.lane;
    for (int pb = blockIdx.x; pb < nblocks; pb += F.G) {
        const int n8 = pb * 32, n0 = nsrc(n8);
        float amax = 0.f;
        for (int kb = kq * 8; kb < kq * 8 + 8; kb += 2) { const int ln = opq(lane); const float* wp = W + (size_t)(64 * kb + (ln >> 5)) * N + n0 + (ln & 31);
            float t[64];
#pragma unroll
            for (int i = 0; i < 64; ++i) t[i] = wp[(size_t)(2 * i) * N];
#pragma unroll
            for (int i = 0; i < 64; ++i) amax = fmaxf(amax, fabsf(t[i])); }
        amax = fmaxf(amax, __shfl_xor(amax, 32));
        if (lane < 32) cmax[kq * 32 + lane] = amax;
        __syncthreads();
        if (kq == 0 && lane < 32) { float mx = 1e-30f;
#pragma unroll
            for (int q = 0; q < 8; ++q) mx = fmaxf(mx, cmax[q * 32 + lane]);
            cinv[lane] = 127.0f / mx; sb[n8 + lane] = mx * (1.0f / 127.0f); }
        __syncthreads();
        for (int kb = kq * 8; kb < kq * 8 + 8; ++kb) { const int k0 = 64 * kb; const int ln = opq(lane);
            const float* wp = W + (size_t)(k0 + (ln >> 5)) * N + n0 + (ln & 31); LAS float* sw = scr + (ln >> 5) * 33 + (ln & 31);
            { float t[32];
#pragma unroll
              for (int i = 0; i < 32; ++i) t[i] = wp[(size_t)(2 * i) * N];
#pragma unroll
              for (int i = 0; i < 32; ++i) sw[2 * i * 33] = t[i]; }
            LDS_WAIT(); asm volatile("" ::: "memory");
            const int c = ln & 7;
#pragma unroll
            for (int j = 0; j < 4; ++j) { const int n = (ln >> 3) + 8 * j; const LAS float* sp = scr + (8 * c) * 33 + n; const float iv = cinv[n];
                v2u o; o.x = pack_i8(sp[0 * 33] * iv, sp[1 * 33] * iv, sp[2 * 33] * iv, sp[3 * 33] * iv); o.y = pack_i8(sp[4 * 33] * iv, sp[5 * 33] * iv, sp[6 * 33] * iv, sp[7 * 33] * iv);
                *(GAS v2u*)(W8 + pg8::tl_off_b(n8 + n, (k0 + 8 * c) >> 1, 2048, true) * 2) = o; }
            LDS_WAIT(); asm volatile("" ::: "memory"); }
        __syncthreads();
    }
}
struct NSrcId { __device__ __forceinline__ int operator()(int n8) const { return n8; } };
struct NSrcIn { __device__ __forceinline__ int operator()(int n8) const { return n8 < 8192 ? n8 : (n8 < 16384 ? n8 + 6144 : (n8 < 18432 ? n8 - 8192 : (n8 < 20480 ? n8 - 6144 : n8 - 10240))); } };
__device__ __forceinline__ void p0_transpose_item8(const float* W, int N, unsigned char* W8, int n_src0, int n8_0, LAS float* scr, int kb, int lane) {
    const int k0 = 64 * kb;
#pragma unroll 8
    for (int i = 0; i < 32; ++i) { const int kk = 2 * i + (lane >> 5); scr[kk * 33 + (lane & 31)] = W[(size_t)(k0 + kk) * N + n_src0 + (lane & 31)]; }
    LDS_WAIT(); asm volatile("" ::: "memory");
    const int c = lane & 7;
#pragma unroll
    for (int j = 0; j < 4; ++j) { const int n = (lane >> 3) + 8 * j; const LAS float* sp = scr + (8 * c) * 33 + n;
        unsigned lo = 0u, hi = 0u;
        lo = __builtin_amdgcn_cvt_pk_fp8_f32(sp[0 * 33] * 64.f, sp[1 * 33] * 64.f, lo, false); lo = __builtin_amdgcn_cvt_pk_fp8_f32(sp[2 * 33] * 64.f, sp[3 * 33] * 64.f, lo, true);
        hi = __builtin_amdgcn_cvt_pk_fp8_f32(sp[4 * 33] * 64.f, sp[5 * 33] * 64.f, hi, false); hi = __builtin_amdgcn_cvt_pk_fp8_f32(sp[6 * 33] * 64.f, sp[7 * 33] * 64.f, hi, true);
        v2u o; o.x = lo; o.y = hi;
        *(GAS v2u*)(W8 + pg8::tl_off_b(n8_0 + n, (k0 + 8 * c) >> 1, 2048, true) * 2) = o; }
    LDS_WAIT(); asm volatile("" ::: "memory");
}
__device__ __forceinline__ void p0_prologue(Frame& F) {
    if ((int)blockIdx.x < 64) { const int p = blockIdx.x; float* E = (float*)(F.ws + WS_ETAB) + p * 2048;
        for (int i = F.tid; i < 1024; i += NWAVES * 64) { const float om = 1.0f / powf(10000.0f, (float)i * (1.0f / 1024.0f)); const float a = (float)p * om; E[i] = sinf(a); E[1024 + i] = cosf(a); } }
    if ((int)blockIdx.x == 64 % F.G) { float* LB = (float*)(F.ws + WS_LB); for (int i = F.tid; i < 4096; i += NWAVES * 64) LB[i] = lb_of(F.lbl, i >> 11, i & 2047); }
    for (int u = blockIdx.x; u < 192; u += F.G) p0_mod_unit(F, u);
    __syncthreads();
    LAS float* scr = (LAS float*)(F.lds + RING_OFF + F.wave * 16384);
    const int gw = blockIdx.x * NWAVES + F.wave, NGW = F.G * NWAVES;
    quant_cols(F, F.w_in, NIN, (16384 + I8_GV * 4096 + I8_U * 2048) / 32, (unsigned char*)(F.ws + WS_WIN8), (float*)(F.ws + WS_SB0), NSrcIn());
    constexpr int NBLO = I8_GV ? 64 : 0, NB16 = I8_U ? 0 : (I8_GV ? 64 : 192), I_BF = (D / 64) * NB16, I_IN = I_BF, I_PA = (AW / 64) * (D / 32), I_PB = I_PA, I_OUT = (D / 64) * (D / 32);
    constexpr int NITEMS = I_IN + I_PA + I_PB + I_OUT;
    for (int it = gw; it < NITEMS; it += NGW) {
        int r = it;
        if (NB16 > 0 && r < I_BF) { const int kb = r / (NB16 > 0 ? NB16 : 1), nb = 256 + NBLO + r % (NB16 > 0 ? NB16 : 1);
            p0_transpose_item(F.w_in, NIN, (bf16*)(F.ws + WS_WINB) - (size_t)32 * 64 * 16384, D, 0, true, scr, kb * (NIN / 32) + nb, F.lane); continue; }
        r -= I_IN;
        if (r < I_PA) { p0_transpose_item(F.w_proj_a, D, (bf16*)(F.ws + WS_WPAB), D, 0, true, scr, r, F.lane); continue; } r -= I_PA;
        if (r < I_PB) { p0_transpose_item(F.w_proj_b, D, (bf16*)(F.ws + WS_WPAB), D, 2048, true, scr, r, F.lane); continue; } r -= I_PB;
        p0_transpose_item(F.w_out, D, (bf16*)(F.ws + WS_WOUT), D, 0, false, scr, r, F.lane);
    }
}
__device__ __forceinline__ void ff_weight_copies(Frame& F) {
    quant_cols(F, F.w_ff1, DFF, DFF / 32, (unsigned char*)(F.ws + WS_WFF1), (float*)(F.ws + WS_SB1), NSrcId());
    LAS float* scr = (LAS float*)(F.lds + RING_OFF + F.wave * 16384);
    const int gw = blockIdx.x * NWAVES + F.wave, NGW = F.G * NWAVES;
    constexpr int I_2 = (DFF / 64) * (D / 32);
    for (int it = gw; it < I_2; it += NGW) p0_transpose_item(F.w_ff2, D, (bf16*)(F.ws + WS_WFF2), DFF, 0, false, scr, it, F.lane);
}

__device__ __forceinline__ const float* opqp(const float* p) { asm volatile("" : "+s"(p)); return p; }
__device__ __forceinline__ void ld_row16(const float* p, int lane, f32x4 (&v)[16]) {
    const GAS f32x4* xr = (const GAS f32x4*)p + lane;
#pragma unroll
    for (int j = 0; j < 16; ++j) v[j] = xr[64 * j];
}
__device__ __forceinline__ float ln_center(f32x4 (&v)[16]) {
    float s = 0.f;
#pragma unroll
    for (int j = 0; j < 16; ++j) s += (v[j].x + v[j].y) + (v[j].z + v[j].w);
    const float mean = wave_sum(s) * (1.f / D); float s2 = 0.f;
#pragma unroll
    for (int j = 0; j < 16; ++j) { v[j] = v[j] - mean; s2 += (v[j].x * v[j].x + v[j].y * v[j].y) + (v[j].z * v[j].z + v[j].w * v[j].w); }
    return 1.f / sqrtf(wave_sum(s2) * (1.f / D) + LN_EPS);
}
__device__ __forceinline__ void adaln_store(int lane, int m, f32x4 (&v)[16], float rstd, const float* shift, const float* scale, bf16* hb, unsigned char* h8 = nullptr, float* sa = nullptr) {
    const GAS f32x4* sh = (const GAS f32x4*)opqp(shift) + lane; const GAS f32x4* sc = (const GAS f32x4*)opqp(scale) + lane;
    bf16* const ob = hb + pg8::tl_off(m, 4 * lane, D);
    float amax = 0.f;
#pragma unroll
    for (int j = 0; j < 16; ++j) { const f32x4 a = sh[64 * j], b = sc[64 * j]; const f32x4 y = v[j] * rstd * (b + 1.0f) + a; if (hb) { v2u w; w.x = pk2(y.x, y.y); w.y = pk2(y.z, y.w); *(GAS v2u*)(ob + (size_t)j * 4 * 16384) = w; }
        v[j] = y; amax = fmaxf(amax, fmaxf(fmaxf(fabsf(y.x), fabsf(y.y)), fmaxf(fabsf(y.z), fabsf(y.w))));
        if ((j & 3) == 3) asm volatile("" ::: "memory"); }
    if (h8) {
        amax = wave_max(amax);
        amax = fmaxf(amax, 1e-20f);
        if (lane == 0) sa[m] = amax * (1.0f / 127.0f);
        const float inv = 127.0f / amax;
        unsigned char* const o8 = h8 + pg8::tl_off(m, 2 * lane, 2048) * 2;
#pragma unroll
        for (int j = 0; j < 16; ++j) *(GAS unsigned*)(o8 + (size_t)j * 2 * 16384 * 2) = pack_i8(v[j].x * inv, v[j].y * inv, v[j].z * inv, v[j].w * inv); }
}
__device__ __forceinline__ const float* p1_src(Frame& F, int m) { return m < M ? F.x + (size_t)m * D : F.ctx + (size_t)(m - M) * D; }
__device__ __forceinline__ void p1_process(Frame& F, int lane, int m, f32x4 (&v)[16]) {
    const bool isx = m < M;
    const float* mod = isx ? (const float*)(F.ws + WS_MODX) + (size_t)(m >> 12) * 24576 : (const float*)(F.ws + WS_MODC);
    if (isx) { const float* E = (const float*)(F.ws + WS_ETAB); const int t = m & 4095, pr = t >> 6, pc = t & 63;
        const GAS f32x4* e0 = (const GAS f32x4*)(E + pr * 2048) + lane; const GAS f32x4* e1 = (const GAS f32x4*)(E + pc * 2048) + lane;
#pragma unroll
        for (int j = 0; j < 8; ++j) { v[j] += e0[64 * j]; v[8 + j] += e1[64 * j]; } }
    const float rstd = ln_center(v);
    adaln_store(lane, m, v, rstd, mod, mod + 4096, I8_U ? (bf16*)nullptr : (bf16*)(F.ws + WS_HBUF), (unsigned char*)(F.ws + WS_H8), (float*)(F.ws + WS_SA1));
}
__device__ __forceinline__ void adaln_store_l(int lane, int m, f32x4 (&v)[16], float rstd, const LAS f32x4* shl, const LAS f32x4* scl, unsigned char* h8, float* sa) {
    float amax = 0.f;
#pragma unroll
    for (int j = 0; j < 16; ++j) { const f32x4 a = shl[64 * j], b = scl[64 * j]; const f32x4 y = v[j] * rstd * (b + 1.0f) + a;
        v[j] = y; amax = fmaxf(amax, fmaxf(fmaxf(fabsf(y.x), fabsf(y.y)), fmaxf(fabsf(y.z), fabsf(y.w)))); }
    amax = wave_max(amax);
    amax = fmaxf(amax, 1e-20f);
    if (lane == 0) sa[m] = amax * (1.0f / 127.0f);
    const float inv = 127.0f / amax;
    unsigned char* const o8 = h8 + pg8::tl_off(m, 2 * lane, 2048) * 2;
#pragma unroll
    for (int j = 0; j < 16; ++j) *(GAS unsigned*)(o8 + (size_t)j * 2 * 16384 * 2) = pack_i8(v[j].x * inv, v[j].y * inv, v[j].z * inv, v[j].w * inv);
}
__device__ __forceinline__ void p1_addE(Frame& F, int lane, int m, f32x4 (&v)[16]) {
    if (m < M) { const float* E = (const float*)(F.ws + WS_ETAB); const int t = m & 4095, pr = t >> 6, pc = t & 63;
        const GAS f32x4* e0 = (const GAS f32x4*)(E + pr * 2048) + lane; const GAS f32x4* e1 = (const GAS f32x4*)(E + pc * 2048) + lane;
        f32x4 e[16];
#pragma unroll
        for (int j = 0; j < 8; ++j) { e[j] = e0[64 * j]; e[8 + j] = e1[64 * j]; }
        asm volatile("" : "+v"(e[0]), "+v"(e[1]), "+v"(e[2]), "+v"(e[3]), "+v"(e[4]), "+v"(e[5]), "+v"(e[6]), "+v"(e[7]), "+v"(e[8]), "+v"(e[9]), "+v"(e[10]), "+v"(e[11]), "+v"(e[12]), "+v"(e[13]), "+v"(e[14]), "+v"(e[15]));
#pragma unroll
        for (int j = 0; j < 16; ++j) v[j] += e[j]; }
}
__device__ __forceinline__ void p1_finish(Frame& F, int lane_, int m, f32x4 (&v)[16], const LAS float* SHb) {
    const int lane = opq(lane_); const LAS f32x4* shl = (const LAS f32x4*)SHb + lane; const LAS f32x4* scl = shl + 1024;
    const float rstd = ln_center(v);
    adaln_store_l(lane, m, v, rstd, shl, scl, (unsigned char*)(F.ws + WS_H8), (float*)(F.ws + WS_SA1));
}
__device__ __forceinline__ void p1_rows(Frame& F) {
    const int gw = blockIdx.x * NWAVES + F.wave, NGW = F.G * NWAVES;
    LAS float* SH = (LAS float*)(F.lds + RING_OFF);
    f32x4 a[16], b[16]; const int lane = opq(F.tid & 63);
    for (int seg = 0; seg < 5; ++seg) {
        const int base = seg < 4 ? seg * 4096 : M, nrows = seg < 4 ? 4096 : MC;
        const float* mod = seg < 4 ? (const float*)(F.ws + WS_MODX) + (size_t)seg * 24576 : (const float*)(F.ws + WS_MODC);
        const int r0 = gw;
        if (r0 < nrows) ld_row16(p1_src(F, base + r0), lane, a);
        for (int i = F.tid; i < 2048; i += NWAVES * 64) ((LAS f32x4*)SH)[i] = ((const GAS f32x4*)mod)[i];
        __syncthreads();
        for (int r = r0; r < nrows; r += 2 * NGW) { const int r1 = r + NGW, r2 = r + 2 * NGW;
            p1_addE(F, lane, base + r, a);
            if (r1 < nrows) ld_row16(p1_src(F, base + r1), lane, b);
            p1_finish(F, lane, base + r, a, SH);
            if (r1 < nrows) { p1_addE(F, lane, base + r1, b); if (r2 < nrows) ld_row16(p1_src(F, base + r2), lane, a); p1_finish(F, lane, base + r1, b, SH); } }
        __syncthreads();
    }
}

__device__ __forceinline__ void scan_naive_unit(Frame& F, int unit) {
    const int dir = unit & 1, vh = (unit >> 1) & 1, h = (unit >> 2) & 15, b = unit >> 6;
    LAS float* fq = (LAS float*)(F.lds + RING_OFF);
    LAS float* kq = fq + 32 * 128; LAS float* qq = kq + 32 * 128;
    LAS float* vv = qq + 32 * 128;
    LAS float* red = vv + 32 * 64;
    const bf16* P = (const bf16*)(F.ws + WS_P);
    const bf16* qh = P; const bf16* vi = P + pg8::SZ4; const bf16* zz = P + (size_t)(2 + dir) * pg8::SZ4;
    float* obuf = (float*)(F.ws + WS_OBUF) + (size_t)dir * M * AW;
    float S[16];
#pragma unroll
    for (int i = 0; i < 16; ++i) S[i] = 0.f;
    for (int n0 = 0; n0 < CTXL + T; n0 += 32) {
#pragma unroll
        for (int j = 0; j < 8; ++j) { const int idx = F.tid + 512 * j, tok = idx >> 7, k = idx & 127, n = n0 + tok;
            const int row = (n < CTXL) ? (M + b * CTXL + (dir ? CTXL - 1 - n : n)) : (b * T + (dir ? T - 1 - (n - CTXL) : (n - CTXL)));
            const int ch = h * 128 + k; const float z = bf2f(zz[(size_t)row * AW + ch]); const float lb = lb_of(F.lbl, dir, ch);
            const float sg = 1.0f / (1.0f + expf(-z));
            fq[idx] = lb + (1.0f - lb) * sg; kq[idx] = (1.0f - lb) * (1.0f - sg); qq[idx] = bf2f(qh[(size_t)row * AW + ch]); }
#pragma unroll
        for (int j = 0; j < 4; ++j) { const int idx = F.tid + 512 * j, tok = idx >> 6, v = idx & 63, n = n0 + tok;
            const int row = (n < CTXL) ? (M + b * CTXL + (dir ? CTXL - 1 - n : n)) : (b * T + (dir ? T - 1 - (n - CTXL) : (n - CTXL)));
            vv[idx] = bf2f(vi[(size_t)row * AW + h * 128 + vh * 64 + v]); }
        __syncthreads();
        for (int tok = 0; tok < 32; ++tok) { const float vval = vv[tok * 64 + F.lane]; float part = 0.f;
#pragma unroll
            for (int kk = 0; kk < 16; ++kk) { const int o = tok * 128 + F.wave * 16 + kk; S[kk] = fq[o] * S[kk] + kq[o] * vval; part += S[kk] * qq[o]; }
            red[(tok * 8 + F.wave) * 64 + F.lane] = part; }
        __syncthreads();
        if (n0 >= CTXL) {
#pragma unroll
            for (int j = 0; j < 4; ++j) { const int idx = F.tid + 512 * j, tok = idx >> 6, v = idx & 63, n = n0 + tok; float s = 0.f;
#pragma unroll
                for (int w = 0; w < 8; ++w) s += red[(tok * 8 + w) * 64 + v];
                const int row = b * T + (dir ? T - 1 - (n - CTXL) : (n - CTXL));
                obuf[(size_t)row * AW + h * 128 + vh * 64 + v] = s; } }
        __syncthreads();
    }
}
__device__ __forceinline__ void vb_stats_rows(Frame& F) {
    const int gw = blockIdx.x * NWAVES + F.wave, NGW = F.G * NWAVES;
    const bf16* vB = (const bf16*)(F.ws + WS_P) + 4 * pg8::SZ4 + 2 * pg8::SZ3;
    for (int m = gw; m < M; m += NGW) {
        const GAS v4u* r = (const GAS v4u*)(vB + (size_t)m * BW) + F.lane;
        float v[32]; float s = 0.f;
#pragma unroll
        for (int j = 0; j < 4; ++j) { const v4u w = r[64 * j]; v[8 * j] = bflo(w.x); v[8 * j + 1] = bfhi(w.x); v[8 * j + 2] = bflo(w.y); v[8 * j + 3] = bfhi(w.y); v[8 * j + 4] = bflo(w.z); v[8 * j + 5] = bfhi(w.z); v[8 * j + 6] = bflo(w.w); v[8 * j + 7] = bfhi(w.w); }
#pragma unroll
        for (int j = 0; j < 32; ++j) s += v[j];
        const float mean = wave_sum(s) * (1.f / BW); float s2 = 0.f;
#pragma unroll
        for (int j = 0; j < 32; ++j) { const float d = v[j] - mean; s2 += d * d; }
        const float rstd = 1.f / sqrtf(wave_sum(s2) * (1.f / BW) + LN_EPS);
        if (F.lane == 0) { float* st = (float*)(F.ws + WS_STAT) + 2 * m; st[0] = mean; st[1] = rstd; }
    }
}
__device__ __forceinline__ void readout_rows(Frame& F) {
    const int gw = blockIdx.x * NWAVES + F.wave, NGW = F.G * NWAVES;
    const float* of = (const float*)(F.ws + WS_OBUF); const float* ob = of + (size_t)M * AW;
    const bf16* sg = (const bf16*)(F.ws + WS_P) + 4 * pg8::SZ4;
    bf16* Y = (bf16*)(F.ws + WS_Y);
    for (int m = gw; m < M; m += NGW) {
        const int c0 = 32 * F.lane; float o[32]; float ss = 0.f;
#pragma unroll
        for (int j = 0; j < 8; ++j) { const f32x4 a = *(const GAS f32x4*)(of + (size_t)m * AW + c0 + 4 * j), b = *(const GAS f32x4*)(ob + (size_t)m * AW + c0 + 4 * j); const f32x4 t = a + b;
            o[4 * j] = t.x; o[4 * j + 1] = t.y; o[4 * j + 2] = t.z; o[4 * j + 3] = t.w; ss += (t.x * t.x + t.y * t.y) + (t.z * t.z + t.w * t.w); }
        ss += __shfl_xor(ss, 1); ss += __shfl_xor(ss, 2);
        const float r = 1.0f / sqrtf(ss * (1.f / HV) + LN_EPS);
        const int v0 = c0 & 127;
#pragma unroll
        for (int j = 0; j < 4; ++j) { const v4u g = *(const GAS v4u*)(sg + (size_t)m * AW + c0 + 8 * j); const float gg[8] = {bflo(g.x), bfhi(g.x), bflo(g.y), bfhi(g.y), bflo(g.z), bfhi(g.z), bflo(g.w), bfhi(g.w)};
            float y[8];
#pragma unroll
            for (int e = 0; e < 8; ++e) y[e] = o[8 * j + e] * r * F.a_norm_g[v0 + 8 * j + e] * gg[e];
            v4u w; w.x = pk2(y[0], y[1]); w.y = pk2(y[2], y[3]); w.z = pk2(y[4], y[5]); w.w = pk2(y[6], y[7]);
            *(GAS v4u*)(Y + pg8::tl_off(m, c0 + 8 * j, D)) = w; }
    }
}
__device__ __forceinline__ void chunkmix_naive_unit(Frame& F, int unit) {
    const int g = unit & 15, n = (unit >> 4) & 31, b = unit >> 9;
    LAS float* vn = (LAS float*)(F.lds + RING_OFF);
    LAS float* wT = vn + 128 * 128;
    const bf16* uB = (const bf16*)(F.ws + WS_P) + 4 * pg8::SZ4 + pg8::SZ3; const bf16* vB = uB + pg8::SZ3;
    const float* st = (const float*)(F.ws + WS_STAT);
    const int row0 = b * T + n * MIXC;
    for (int i = F.tid; i < 128 * 128; i += NWAVES * 64) { const int s = i >> 7, c = i & 127; const int row = row0 + s;
        const float x = bf2f(vB[(size_t)row * BW + g * 128 + c]);
        vn[i] = (x - st[2 * row]) * st[2 * row + 1] * F.v_norm_g[g * 128 + c] + F.v_norm_b[g * 128 + c];
        const int t = i >> 7, s2 = i & 127; wT[s2 * 128 + t] = F.w_s[(size_t)g * 16384 + t * 128 + s2]; }
    __syncthreads();
    const int c = F.tid & 127, t0 = (F.tid >> 7) * 32;
    float acc[32];
#pragma unroll
    for (int i = 0; i < 32; ++i) acc[i] = 0.f;
    for (int s = 0; s < 128; ++s) { const float x = vn[s * 128 + c];
#pragma unroll
        for (int i = 0; i < 32; ++i) acc[i] += wT[s * 128 + t0 + i] * x; }
    bf16* Y = (bf16*)(F.ws + WS_Y);
#pragma unroll
    for (int i = 0; i < 32; ++i) { const int t = t0 + i, row = row0 + t; const float mixed = acc[i] + F.b_s[g * 128 + t];
        const float uu = bf2f(uB[(size_t)row * BW + g * 128 + c]);
        Y[pg8::tl_off(row, 2048 + g * 128 + c, D)] = (bf16)f2bf(uu * mixed); }
    __syncthreads();
}

typedef short bf16x8 __attribute__((ext_vector_type(8)));
typedef short bf16x4 __attribute__((ext_vector_type(4)));
#define MFMA16(a, b, c) __builtin_amdgcn_mfma_f32_16x16x32_bf16((a), (b), (c), 0, 0, 0)
__device__ __forceinline__ float fexp(float x) { return __builtin_amdgcn_exp2f(x); }
__device__ __forceinline__ void gate_of(float z, float lb, float& lf, float& kk) { const float sg = sigm(z); lf = __builtin_amdgcn_logf(lb + (1.0f - lb) * sg); kk = (1.0f - lb) * (1.0f - sg); }
__device__ __forceinline__ void stage_vT(LAS bf16* VT, const bf16* vsrc, int tid) {
#pragma unroll
    for (int j = 0; j < 2; ++j) { const int idx = tid + 512 * j, sl = idx >> 4, c8 = (idx & 15) * 8; const v4u w = *(const GAS v4u*)(vsrc + (size_t)sl * AW + c8);
        VT[(c8 + 0) * 72 + sl] = (bf16)(w.x & 0xffffu); VT[(c8 + 1) * 72 + sl] = (bf16)(w.x >> 16); VT[(c8 + 2) * 72 + sl] = (bf16)(w.y & 0xffffu); VT[(c8 + 3) * 72 + sl] = (bf16)(w.y >> 16);
        VT[(c8 + 4) * 72 + sl] = (bf16)(w.z & 0xffffu); VT[(c8 + 5) * 72 + sl] = (bf16)(w.z >> 16); VT[(c8 + 6) * 72 + sl] = (bf16)(w.w & 0xffffu); VT[(c8 + 7) * 72 + sl] = (bf16)(w.w >> 16); }
}
__device__ __forceinline__ void scanA_ld(Frame& F, int unit, v4u (&zr)[2], v4u (&vr)[2]) {
    const int cidx = unit % 68; int r0 = unit / 68; const int h = r0 & 15; r0 >>= 4; const int b = r0 & 3, dir = r0 >> 2;
    const int row0 = (cidx < 4) ? (M + b * CTXL + cidx * 64) : (b * T + (cidx - 4) * 64);
    const bf16* P = (const bf16*)(F.ws + WS_P);
    const bf16* zz = P + (size_t)(2 + dir) * pg8::SZ4 + (size_t)row0 * AW + h * 128; const bf16* vv = P + pg8::SZ4 + (size_t)row0 * AW + h * 128;
#pragma unroll
    for (int j = 0; j < 2; ++j) { const int idx = F.tid + 512 * j, sl = idx >> 4, c8 = (idx & 15) * 8; zr[j] = *(const GAS v4u*)(zz + (size_t)sl * AW + c8); vr[j] = *(const GAS v4u*)(vv + (size_t)sl * AW + c8); }
}
__device__ __forceinline__ int scanA_unit_of(int l, int half) { const int per = 2 * 16 * 68, dir = l / per, r = l - dir * per; return (dir * 4 + 2 * half) * 16 * 68 + r; }
__device__ __forceinline__ void scanA_phase(Frame& F, int half) {
    int lu = blockIdx.x; if (lu >= 4352) return;
    int unit = scanA_unit_of(lu, half);
    LAS bf16* KT = (LAS bf16*)(F.lds + RING_OFF);
    LAS bf16* VT = (LAS bf16*)(F.lds + RING_OFF + 18432);
    LAS float* TOT = (LAS float*)(F.lds + RING_OFF + 36992);
    LAS bf16* ZS = (LAS bf16*)(F.lds + RING_OFF + 39040);
    v4u zr[2], vr[2];
    scanA_ld(F, unit, zr, vr);
    float lbn = ((const float*)(F.ws + WS_LB))[((unit / 68) >> 6) * 2048 + ((unit / 68) & 15) * 128 + (F.tid & 127)];
    for (; lu < 4352; lu += F.G, unit = scanA_unit_of(lu < 4352 ? lu : 0, half)) {
        const int cidx = unit % 68; int r0 = unit / 68; const int h = r0 & 15; r0 >>= 4; const int dir = r0 >> 2;
#pragma unroll
        for (int j = 0; j < 2; ++j) { const int idx = F.tid + 512 * j, sl = idx >> 4, c8 = (idx & 15) * 8; const v4u wv = vr[j];
            *(LAS v4u*)(ZS + sl * 136 + c8) = zr[j];
            LAS bf16* vp = VT + c8 * 72 + (c8 >> 4) * 8 + sl;
            vp[0 * 72] = (bf16)(wv.x & 0xffffu); vp[1 * 72] = (bf16)(wv.x >> 16); vp[2 * 72] = (bf16)(wv.y & 0xffffu); vp[3 * 72] = (bf16)(wv.y >> 16);
            vp[4 * 72] = (bf16)(wv.z & 0xffffu); vp[5 * 72] = (bf16)(wv.z >> 16); vp[6 * 72] = (bf16)(wv.w & 0xffffu); vp[7 * 72] = (bf16)(wv.w >> 16); }
        __syncthreads();
        const float lb = lbn;
        if (lu + F.G < 4352) { const int nu = scanA_unit_of(lu + F.G, half); scanA_ld(F, nu, zr, vr); lbn = ((const float*)(F.ws + WS_LB))[((nu / 68) >> 6) * 2048 + ((nu / 68) & 15) * 128 + (F.tid & 127)]; }
        const int kch = F.tid & 127, sq = F.tid >> 7;
        float lf[16], kk[16]; float tot = 0.f;
#pragma unroll
        for (int e = 0; e < 16; ++e) { gate_of(bf2f(ZS[(16 * sq + e) * 136 + kch]), lb, lf[e], kk[e]); tot += lf[e]; }
        TOT[sq * 128 + kch] = tot;
        __syncthreads();
        float aft = 0.f;
#pragma unroll
        for (int q = 0; q < 4; ++q) { const float tq = TOT[q * 128 + kch]; if (dir ? (q < sq) : (q > sq)) aft += tq; }
        float kt[16]; float run = aft;
        if (dir == 0) {
#pragma unroll
            for (int e = 15; e >= 0; --e) { kt[e] = kk[e] * fexp(run); run += lf[e]; }
        } else {
#pragma unroll
            for (int e = 0; e < 16; ++e) { kt[e] = kk[e] * fexp(run); run += lf[e]; }
        }
        { v4u w0, w1; w0.x = pk2(kt[0], kt[1]); w0.y = pk2(kt[2], kt[3]); w0.z = pk2(kt[4], kt[5]); w0.w = pk2(kt[6], kt[7]); w1.x = pk2(kt[8], kt[9]); w1.y = pk2(kt[10], kt[11]); w1.z = pk2(kt[12], kt[13]); w1.w = pk2(kt[14], kt[15]);
          LAS v4u* kp = (LAS v4u*)(KT + kch * 72 + 16 * sq); kp[0] = w0; kp[1] = w1; }
        if (sq == 0) ((float*)(F.ws + WS_DSUM))[(size_t)unit * 128 + kch] = fexp((TOT[kch] + TOT[128 + kch]) + (TOT[256 + kch] + TOT[384 + kch]));
        __syncthreads();
        const int fr = F.lane & 15, fq = F.lane >> 4, w = F.wave;
        const bf16x8 a0 = *(const LAS bf16x8*)(KT + (16 * w + fr) * 72 + 8 * fq), a1 = *(const LAS bf16x8*)(KT + (16 * w + fr) * 72 + 32 + 8 * fq);
        bf16* ST = (bf16*)(F.ws + WS_LBUF) + (size_t)unit * 16384;
#pragma unroll
        for (int vb = 0; vb < 8; ++vb) {
            const bf16x8 b0 = *(const LAS bf16x8*)(VT + (16 * vb + fr) * 72 + 8 * vb + 8 * fq), b1 = *(const LAS bf16x8*)(VT + (16 * vb + fr) * 72 + 8 * vb + 32 + 8 * fq);
            f32x4 acc = {0.f, 0.f, 0.f, 0.f}; acc = MFMA16(a0, b0, acc); acc = MFMA16(a1, b1, acc);
            v2u o; o.x = pk2(acc[0], acc[1]); o.y = pk2(acc[2], acc[3]);
            *(GAS v2u*)(ST + (size_t)(16 * vb + fr) * 128 + 16 * w + 4 * fq) = o; }
        __syncthreads();
    }
}
__device__ __forceinline__ int scanB_cidx(int dir, int step) { return dir ? (step < 4 ? 3 - step : 71 - step) : step; }
__device__ __forceinline__ void scanB(Frame& F, int half) {
    for (int cu = blockIdx.x; cu < 256; cu += F.G) {
        const int cl = cu >> 2, dir = cl >> 5, chain = (dir * 4 + 2 * half) * 16 + (cl & 31), v = (cu & 3) * 32 + (F.tid >> 4), kg = F.tid & 15;
        bf16* Lb = (bf16*)(F.ws + WS_LBUF) + (size_t)chain * 68 * 16384 + (size_t)v * 128 + 8 * kg;
        const float* Db = (const float*)(F.ws + WS_DSUM) + (size_t)chain * 68 * 128 + 8 * kg;
        float S[8];
#pragma unroll
        for (int i = 0; i < 8; ++i) S[i] = 0.f;
        v4u l0[4]; f32x4 dq[4][2];
#define SB_LOAD(slot, step_) do { const int c_ = scanB_cidx(dir, (step_) < 68 ? (step_) : 67); \
            l0[slot] = *(const GAS v4u*)(Lb + (size_t)c_ * 16384); \
            dq[slot][0] = *(const GAS f32x4*)(Db + c_ * 128); dq[slot][1] = *(const GAS f32x4*)(Db + c_ * 128 + 4); } while (0)
        SB_LOAD(0, 0); SB_LOAD(1, 1); SB_LOAD(2, 2);
        for (int s0 = 0; s0 < 68; s0 += 4) {
#pragma unroll
            for (int u = 0; u < 4; ++u) { const int step = s0 + u, cidx = scanB_cidx(dir, step);
                SB_LOAD((u + 3) & 3, step + 3);
                if (cidx >= 4) { v4u o0; o0.x = pk2(S[0], S[1]); o0.y = pk2(S[2], S[3]); o0.z = pk2(S[4], S[5]); o0.w = pk2(S[6], S[7]); *(GAS v4u*)(Lb + (size_t)cidx * 16384) = o0; }
                const float dd[8] = {dq[u][0].x, dq[u][0].y, dq[u][0].z, dq[u][0].w, dq[u][1].x, dq[u][1].y, dq[u][1].z, dq[u][1].w};
                const float ll[8] = {bflo(l0[u].x), bfhi(l0[u].x), bflo(l0[u].y), bfhi(l0[u].y), bflo(l0[u].z), bfhi(l0[u].z), bflo(l0[u].w), bfhi(l0[u].w)};
#pragma unroll
                for (int i = 0; i < 8; ++i) S[i] = dd[i] * S[i] + ll[i]; }
        }
#undef SB_LOAD
    }
}
template <int CTRL> __device__ __forceinline__ float dppf(float x) { return __builtin_bit_cast(float, __builtin_amdgcn_update_dpp(0, __builtin_bit_cast(int, x), CTRL, 0xf, 0xf, true)); }
constexpr int SC_KB = 0, SC_VT = 34816, SC_TOT = 53376, SC_SS = 61568;
__device__ __forceinline__ void scanC_dma(Frame& F, int unit) {
    const int c = unit & 63, h = (unit >> 6) & 15, b = unit >> 10, w = F.wave, fr = F.lane & 15, fq = F.lane >> 4;
#pragma unroll
    for (int j = 0; j < 8; ++j) { const int chunk = w * 8 + j, sd = chunk >> 5, v = ((chunk & 31) << 2) + fq, cp = fr;
        const bf16* src = (const bf16*)(F.ws + WS_LBUF) + ((size_t)(((sd * 4 + b) * 16 + h) * 68 + 4 + c)) * 16384 + v * 128 + ((cp ^ (v & 15)) << 3);
        __builtin_amdgcn_global_load_lds((const unsigned*)src, (LAS unsigned*)(F.lds + RING_OFF + SC_SS + chunk * 1024), 16, 0, 0); }
}
__device__ __forceinline__ void scanC_ldzv(Frame& F, int unit, v4u (&zw)[4], v4u (&vw)[2]) {
    const int c = unit & 63, h = (unit >> 6) & 15, b = unit >> 10, row0 = b * T + c * 64, w = F.wave, dir = w >> 2, tl = 16 * (w & 3) + (F.lane & 15), fq = F.lane >> 4;
    const bf16* P = (const bf16*)(F.ws + WS_P);
    const bf16* zz = P + (size_t)(2 + dir) * pg8::SZ4 + (size_t)(row0 + tl) * AW + h * 128 + 8 * fq;
#pragma unroll
    for (int kk = 0; kk < 4; ++kk) zw[kk] = *(const GAS v4u*)(zz + 32 * kk);
    const bf16* vsrc = P + pg8::SZ4 + (size_t)row0 * AW + h * 128;
#pragma unroll
    for (int j = 0; j < 2; ++j) { const int idx = F.tid + 512 * j, sl = idx >> 4, c8 = (idx & 15) * 8; vw[j] = *(const GAS v4u*)(vsrc + (size_t)sl * AW + c8); }
}
__device__ __forceinline__ void scanC_phase(Frame& F, int half) {
    const int uend = (half + 1) * 2048;
    int unit = half * 2048 + blockIdx.x; if (unit >= uend) return;
    v4u zw[4], vw[2];
    scanC_dma(F, unit); scanC_ldzv(F, unit, zw, vw);
    LAS float* LBS = (LAS float*)(F.lds + LDSCTL_OFF + 2048);
    LAS float* GNS = (LAS float*)(F.lds + LDSCTL_OFF + 4096);
    if (F.tid < 256) LBS[F.tid] = ((const float*)(F.ws + WS_LB))[(F.tid >> 7) * 2048 + ((unit >> 6) & 15) * 128 + (F.tid & 127)];
    if (F.tid < 128) GNS[F.tid] = F.a_norm_g[F.tid];
    __syncthreads();
  for (; unit < uend; unit += F.G) {
    const int nunit = unit + F.G;
    const int c = unit & 63, h = (unit >> 6) & 15, b = unit >> 10;
    const int row0 = b * T + c * 64;
    LAS bf16* KB = (LAS bf16*)(F.lds + RING_OFF + SC_KB);
    LAS bf16* VT = (LAS bf16*)(F.lds + RING_OFF + SC_VT);
    LAS float* TOT = (LAS float*)(F.lds + RING_OFF + SC_TOT);
    LAS bf16* SS = (LAS bf16*)(F.lds + RING_OFF + SC_SS);
    LAS float* OB = (LAS float*)(F.lds + RING_OFF + SC_KB);
    const bf16* P = (const bf16*)(F.ws + WS_P);
    const int w = F.wave, dir = w >> 2, i = w & 3, pi = dir ? 3 - i : i, fr = F.lane & 15, fq = F.lane >> 4, tl = 16 * i + fr;
    v4u qw[4];
    { const bf16* qq = P + (size_t)(row0 + tl) * AW + h * 128 + 8 * fq;
#pragma unroll
      for (int kk = 0; kk < 4; ++kk) qw[kk] = *(const GAS v4u*)(qq + 32 * kk); }
#pragma unroll
    for (int j = 0; j < 2; ++j) { const int idx = opq(F.tid) + 512 * j, sl = idx >> 4, c8 = (idx & 15) * 8; const v4u wv = vw[j];
        LAS bf16* vp = VT + c8 * 72 + (c8 >> 4) * 8 + sl;
        vp[0 * 72] = (bf16)(wv.x & 0xffffu); vp[1 * 72] = (bf16)(wv.x >> 16); vp[2 * 72] = (bf16)(wv.y & 0xffffu); vp[3 * 72] = (bf16)(wv.y >> 16);
        vp[4 * 72] = (bf16)(wv.z & 0xffffu); vp[5 * 72] = (bf16)(wv.z >> 16); vp[6 * 72] = (bf16)(wv.w & 0xffffu); vp[7 * 72] = (bf16)(wv.w >> 16); }
    float cum[4][8], kv[4][8];
    { const LAS float* LB = LBS + dir * 128 + 8 * (opq(F.lane) >> 4);
#pragma unroll
      for (int kk = 0; kk < 4; ++kk) { const f32x4 l0 = *(const LAS f32x4*)(LB + 32 * kk), l1 = *(const LAS f32x4*)(LB + 32 * kk + 4);
          const float lb[8] = {l0.x, l0.y, l0.z, l0.w, l1.x, l1.y, l1.z, l1.w};
          const float z[8] = {bflo(zw[kk].x), bfhi(zw[kk].x), bflo(zw[kk].y), bfhi(zw[kk].y), bflo(zw[kk].z), bfhi(zw[kk].z), bflo(zw[kk].w), bfhi(zw[kk].w)};
#pragma unroll
          for (int e = 0; e < 8; ++e) gate_of(z[e], lb[e], cum[kk][e], kv[kk][e]); } }
    if (dir == 0) {
#pragma unroll
        for (int kk = 0; kk < 4; ++kk)
#pragma unroll
            for (int e = 0; e < 8; ++e) { float x = cum[kk][e]; x += dppf<0x111>(x); x += dppf<0x112>(x); x += dppf<0x114>(x); x += dppf<0x118>(x); cum[kk][e] = x; }
    } else {
#pragma unroll
        for (int kk = 0; kk < 4; ++kk)
#pragma unroll
            for (int e = 0; e < 8; ++e) { float x = cum[kk][e]; x += dppf<0x101>(x); x += dppf<0x102>(x); x += dppf<0x104>(x); x += dppf<0x108>(x); cum[kk][e] = x; }
    }
    if (fr == (dir ? 0 : 15)) {
#pragma unroll
        for (int kk = 0; kk < 4; ++kk) { LAS f32x4* tp = (LAS f32x4*)(TOT + (dir * 4 + pi) * 128 + 32 * kk + 8 * fq);
            tp[0] = (f32x4){cum[kk][0], cum[kk][1], cum[kk][2], cum[kk][3]}; tp[1] = (f32x4){cum[kk][4], cum[kk][5], cum[kk][6], cum[kk][7]};
            tp[256] = (f32x4){fexp(cum[kk][0]), fexp(cum[kk][1]), fexp(cum[kk][2]), fexp(cum[kk][3])}; tp[257] = (f32x4){fexp(cum[kk][4]), fexp(cum[kk][5]), fexp(cum[kk][6]), fexp(cum[kk][7])}; } }
    asm volatile("s_waitcnt vmcnt(0)" ::: "memory");
    __syncthreads();
    if (nunit < uend) scanC_ldzv(F, nunit, zw, vw);
    {
#pragma unroll
      for (int kk = 0; kk < 4; ++kk) { float pre[8] = {0.f, 0.f, 0.f, 0.f, 0.f, 0.f, 0.f, 0.f};
#pragma unroll
          for (int p = 0; p < 3; ++p) if (p < pi) { const f32x4 t0 = *(const LAS f32x4*)(TOT + (dir * 4 + p) * 128 + 32 * kk + 8 * fq), t1 = *(const LAS f32x4*)(TOT + (dir * 4 + p) * 128 + 32 * kk + 8 * fq + 4);
              pre[0] += t0.x; pre[1] += t0.y; pre[2] += t0.z; pre[3] += t0.w; pre[4] += t1.x; pre[5] += t1.y; pre[6] += t1.z; pre[7] += t1.w; }
          const f32x4 m0 = *(const LAS f32x4*)(TOT + (dir * 4 + pi) * 128 + 32 * kk + 8 * fq), m1 = *(const LAS f32x4*)(TOT + (dir * 4 + pi) * 128 + 32 * kk + 8 * fq + 4);
          const float mt[8] = {m0.x, m0.y, m0.z, m0.w, m1.x, m1.y, m1.z, m1.w};
          float kt[8];
#pragma unroll
          for (int e = 0; e < 8; ++e) { const float loc = cum[kk][e]; cum[kk][e] = pre[e] + loc; kt[e] = kv[kk][e] * fexp(mt[e] - loc); }
          v4u ko; ko.x = pk2(kt[0], kt[1]); ko.y = pk2(kt[2], kt[3]); ko.z = pk2(kt[4], kt[5]); ko.w = pk2(kt[6], kt[7]);
          *(LAS v4u*)(KB + (dir * 64 + tl) * 136 + 32 * kk + 8 * fq) = ko; } }
    __syncthreads();
    float E[4][8];
    { float rpi[4][8];
#pragma unroll
      for (int kk = 0; kk < 4; ++kk)
#pragma unroll
          for (int e = 0; e < 8; ++e) rpi[kk][e] = 0.f;
#pragma unroll
      for (int p = 0; p < 4; ++p) if (p <= pi) {
#pragma unroll
          for (int kk = 0; kk < 4; ++kk) { const f32x4 r0 = *(const LAS f32x4*)(TOT + (dir * 4 + p) * 128 + 32 * kk + 8 * fq), r1 = *(const LAS f32x4*)(TOT + (dir * 4 + p) * 128 + 32 * kk + 8 * fq + 4);
              rpi[kk][0] += r0.x; rpi[kk][1] += r0.y; rpi[kk][2] += r0.z; rpi[kk][3] += r0.w; rpi[kk][4] += r1.x; rpi[kk][5] += r1.y; rpi[kk][6] += r1.z; rpi[kk][7] += r1.w; } }
#pragma unroll
      for (int kk = 0; kk < 4; ++kk)
#pragma unroll
          for (int e = 0; e < 8; ++e) E[kk][e] = fexp(cum[kk][e] - rpi[kk][e]); }
    f32x4 att[4];
#pragma unroll
    for (int pj = 3; pj >= 0; --pj) { att[pj] = (f32x4){0.f, 0.f, 0.f, 0.f};
        if (pj <= pi) { const int j = dir ? 3 - pj : pj; f32x4 d = {0.f, 0.f, 0.f, 0.f};
#pragma unroll
            for (int kk = 0; kk < 4; ++kk) {
                v4u qt; qt.x = pk2(bflo(qw[kk].x) * E[kk][0], bfhi(qw[kk].x) * E[kk][1]); qt.y = pk2(bflo(qw[kk].y) * E[kk][2], bfhi(qw[kk].y) * E[kk][3]);
                qt.z = pk2(bflo(qw[kk].z) * E[kk][4], bfhi(qw[kk].z) * E[kk][5]); qt.w = pk2(bflo(qw[kk].w) * E[kk][6], bfhi(qw[kk].w) * E[kk][7]);
                const bf16x8 a = *(const LAS bf16x8*)(KB + (dir * 64 + 16 * j + fr) * 136 + 32 * kk + 8 * fq);
                d = MFMA16(a, __builtin_bit_cast(bf16x8, qt), d);
                const f32x4 t0 = *(const LAS f32x4*)(TOT + 1024 + (dir * 4 + pj) * 128 + 32 * kk + 8 * fq), t1 = *(const LAS f32x4*)(TOT + 1024 + (dir * 4 + pj) * 128 + 32 * kk + 8 * fq + 4);
                E[kk][0] *= t0.x; E[kk][1] *= t0.y; E[kk][2] *= t0.z; E[kk][3] *= t0.w; E[kk][4] *= t1.x; E[kk][5] *= t1.y; E[kk][6] *= t1.z; E[kk][7] *= t1.w; }
            if (pj == pi) {
#pragma unroll
                for (int r = 0; r < 4; ++r) { const int sl = 4 * fq + r; if (dir ? (sl < fr) : (sl > fr)) d[r] = 0.f; } }
            att[pj] = d; } }
    f32x4 o[8];
#pragma unroll
    for (int vb = 0; vb < 8; ++vb) o[vb] = (f32x4){0.f, 0.f, 0.f, 0.f};
#pragma unroll
    for (int pp = 0; pp < 2; ++pp) if (2 * pp <= pi) {
        v4u pb; pb.x = pk2(att[2 * pp][0], att[2 * pp][1]); pb.y = pk2(att[2 * pp][2], att[2 * pp][3]); pb.z = pk2(att[2 * pp + 1][0], att[2 * pp + 1][1]); pb.w = pk2(att[2 * pp + 1][2], att[2 * pp + 1][3]);
        const int j0 = dir ? 3 - 2 * pp : 2 * pp, j1 = dir ? 2 - 2 * pp : 2 * pp + 1;
#pragma unroll
        for (int vb = 0; vb < 8; ++vb) { const v2u lo = *(const LAS v2u*)(VT + (16 * vb + fr) * 72 + 8 * vb + 16 * j0 + 4 * fq), hi = *(const LAS v2u*)(VT + (16 * vb + fr) * 72 + 8 * vb + 16 * j1 + 4 * fq);
            v4u av; av.x = lo.x; av.y = lo.y; av.z = hi.x; av.w = hi.y;
            o[vb] = MFMA16(__builtin_bit_cast(bf16x8, av), __builtin_bit_cast(bf16x8, pb), o[vb]); } }
    v2u gw[8];
    { const bf16* sg = P + 4 * pg8::SZ4 + (size_t)(row0 + tl) * AW + h * 128 + 4 * fq;
#pragma unroll
      for (int vb = 0; vb < 8; ++vb) gw[vb] = *(const GAS v2u*)(sg + 16 * vb); }
#pragma unroll
    for (int kk = 0; kk < 4; ++kk) { v4u qt; qt.x = pk2(bflo(qw[kk].x) * E[kk][0], bfhi(qw[kk].x) * E[kk][1]); qt.y = pk2(bflo(qw[kk].y) * E[kk][2], bfhi(qw[kk].y) * E[kk][3]);
        qt.z = pk2(bflo(qw[kk].z) * E[kk][4], bfhi(qw[kk].z) * E[kk][5]); qt.w = pk2(bflo(qw[kk].w) * E[kk][6], bfhi(qw[kk].w) * E[kk][7]);
#pragma unroll
        for (int vb = 0; vb < 8; ++vb) { const bf16x8 sa = *(const LAS bf16x8*)(SS + (dir * 128 + 16 * vb + fr) * 128 + (((4 * kk + fq) ^ fr) << 3));
            o[vb] = MFMA16(sa, __builtin_bit_cast(bf16x8, qt), o[vb]); } }
    __syncthreads();
    if (nunit < uend) scanC_dma(F, nunit);
    float lbq = 0.f; { const int t_ = opq(F.tid); if (nunit < uend && t_ < 256) lbq = ((const float*)(F.ws + WS_LB))[(t_ >> 7) * 2048 + ((nunit >> 6) & 15) * 128 + (t_ & 127)]; }
    if (dir == 1) {
#pragma unroll
        for (int vb = 0; vb < 8; ++vb) *(LAS f32x4*)(OB + tl * 132 + 16 * vb + 4 * fq) = o[vb]; }
    __syncthreads();
    if (dir == 0) { float ss = 0.f; const LAS float* gnp = GNS + 4 * (opq(F.lane) >> 4);
#pragma unroll
        for (int vb = 0; vb < 8; ++vb) { o[vb] += *(const LAS f32x4*)(OB + tl * 132 + 16 * vb + 4 * fq); ss += (o[vb][0] * o[vb][0] + o[vb][1] * o[vb][1]) + (o[vb][2] * o[vb][2] + o[vb][3] * o[vb][3]); }
        ss += __shfl_xor(ss, 16); ss += __shfl_xor(ss, 32);
        const float rs = 1.0f / sqrtf(ss * (1.f / HV) + LN_EPS);
        bf16* Y = (bf16*)(F.ws + WS_Y);
#pragma unroll
        for (int vb = 0; vb < 8; ++vb) { const int v0 = 16 * vb + 4 * fq; const f32x4 gn = *(const LAS f32x4*)(gnp + 16 * vb);
            v2u yo; yo.x = pk2(o[vb][0] * rs * gn.x * bflo(gw[vb].x), o[vb][1] * rs * gn.y * bfhi(gw[vb].x)); yo.y = pk2(o[vb][2] * rs * gn.z * bflo(gw[vb].y), o[vb][3] * rs * gn.w * bfhi(gw[vb].y));
            *(GAS v2u*)(Y + pg8::tl_off(row0 + tl, h * 128 + v0, D)) = yo; } }
    { const int t_ = opq(F.tid); if (nunit < uend && t_ < 256) LBS[t_] = lbq; }
    __syncthreads();
  }
}
__device__ __forceinline__ void chunkmix_unit(Frame& F, int unit) {
    const int g = unit & 15, n = (unit >> 4) & 31, b = unit >> 9;
    LAS bf16* VN = (LAS bf16*)(F.lds + RING_OFF);
    LAS bf16* WB = (LAS bf16*)(F.lds + RING_OFF + 34816);
    const bf16* uB = (const bf16*)(F.ws + WS_P) + 4 * pg8::SZ4 + pg8::SZ3; const bf16* vB = uB + pg8::SZ3;
    const float* st = (const float*)(F.ws + WS_STAT);
    const int row0 = b * T + n * MIXC;
#pragma unroll
    for (int j = 0; j < 4; ++j) { const int idx = F.tid + 512 * j, sl = idx >> 4, c8 = (idx & 15) * 8; const int row = row0 + sl;
        const v4u w = *(const GAS v4u*)(vB + (size_t)row * BW + g * 128 + c8); const float mu = st[2 * row], rs = st[2 * row + 1];
        const f32x4 g0 = *(const GAS f32x4*)(F.v_norm_g + g * 128 + c8), g1 = *(const GAS f32x4*)(F.v_norm_g + g * 128 + c8 + 4), b0 = *(const GAS f32x4*)(F.v_norm_b + g * 128 + c8), b1 = *(const GAS f32x4*)(F.v_norm_b + g * 128 + c8 + 4);
        const float x[8] = {bflo(w.x), bfhi(w.x), bflo(w.y), bfhi(w.y), bflo(w.z), bfhi(w.z), bflo(w.w), bfhi(w.w)};
        const float gg[8] = {g0.x, g0.y, g0.z, g0.w, g1.x, g1.y, g1.z, g1.w}, bb[8] = {b0.x, b0.y, b0.z, b0.w, b1.x, b1.y, b1.z, b1.w};
#pragma unroll
        for (int e = 0; e < 8; ++e) VN[(c8 + e) * 136 + sl] = (bf16)f2bf((x[e] - mu) * rs * gg[e] + bb[e]); }
#pragma unroll
    for (int j = 0; j < 4; ++j) { const int idx = F.tid + 512 * j, t = idx >> 4, s8 = (idx & 15) * 8; const float* wp = F.w_s + (size_t)g * 16384 + t * 128 + s8;
        const f32x4 a = *(const GAS f32x4*)wp, c = *(const GAS f32x4*)(wp + 4); v4u o; o.x = pk2(a.x, a.y); o.y = pk2(a.z, a.w); o.z = pk2(c.x, c.y); o.w = pk2(c.z, c.w);
        *(LAS v4u*)(WB + t * 136 + s8) = o; }
    __syncthreads();
    const int w = F.wave, fr = F.lane & 15, fq = F.lane >> 4;
    bf16x8 af[4];
#pragma unroll
    for (int ks = 0; ks < 4; ++ks) af[ks] = *(const LAS bf16x8*)(VN + (16 * w + fr) * 136 + 32 * ks + 8 * fq);
    bf16* Y = (bf16*)(F.ws + WS_Y);
#pragma unroll
    for (int tb = 0; tb < 8; ++tb) { f32x4 acc = {0.f, 0.f, 0.f, 0.f};
#pragma unroll
        for (int ks = 0; ks < 4; ++ks) acc = MFMA16(af[ks], *(const LAS bf16x8*)(WB + (16 * tb + fr) * 136 + 32 * ks + 8 * fq), acc);
        const int t = 16 * tb + fr, row = row0 + t, c0 = g * 128 + 16 * w + 4 * fq; const float bs = F.b_s[g * 128 + t];
        const v2u uw = *(const GAS v2u*)(uB + (size_t)row * BW + c0);
        v2u yo; yo.x = pk2(bflo(uw.x) * (acc[0] + bs), bfhi(uw.x) * (acc[1] + bs)); yo.y = pk2(bflo(uw.y) * (acc[2] + bs), bfhi(uw.y) * (acc[3] + bs));
        *(GAS v2u*)(Y + pg8::tl_off(row, 2048 + c0, D)) = yo; }
    __syncthreads();
}

__device__ __forceinline__ void mix_ld(Frame& F, int unit, v4u (&vw)[4], float (&mu)[4], float (&rs)[4], v2u (&uw)[8]) {
    const int g = unit & 15, n = (unit >> 4) & 31, b = unit >> 9, row0 = b * T + n * MIXC, c8 = (F.tid & 15) * 8;
    { const bf16* uB = (const bf16*)(F.ws + WS_P) + 4 * pg8::SZ4 + pg8::SZ3; const int w = F.wave, fr = F.lane & 15, fq = F.lane >> 4;
#pragma unroll
      for (int tb = 0; tb < 8; ++tb) uw[tb] = *(const GAS v2u*)(uB + (size_t)(row0 + 16 * tb + fr) * BW + g * 128 + 16 * w + 4 * fq); }
    const bf16* vB = (const bf16*)(F.ws + WS_P) + 4 * pg8::SZ4 + 2 * pg8::SZ3; const float* st = (const float*)(F.ws + WS_STAT);
#pragma unroll
    for (int j = 0; j < 4; ++j) { const int row = row0 + ((F.tid + 512 * j) >> 4); vw[j] = *(const GAS v4u*)(vB + (size_t)row * BW + g * 128 + c8); mu[j] = st[2 * row]; rs[j] = st[2 * row + 1]; }
}
__device__ __forceinline__ void chunkmix_phase(Frame& F) {
    constexpr int NU = NB * 32 * NG;
    int unit = blockIdx.x; if (unit >= NU) return;
    LAS bf16* VN = (LAS bf16*)(F.lds + RING_OFF);
    LAS bf16* WB = (LAS bf16*)(F.lds + RING_OFF + 34944);
    const bf16* uB = (const bf16*)(F.ws + WS_P) + 4 * pg8::SZ4 + pg8::SZ3;
    bf16* Y = (bf16*)(F.ws + WS_Y);
    const int w = F.wave, fr = F.lane & 15, fq = F.lane >> 4, c8 = (F.tid & 15) * 8;
    int gcur = -1; float gg[8], bb[8], bs[8];
    v4u vw[4]; float mu[4], rs[4]; v2u un[8];
    mix_ld(F, unit, vw, mu, rs, un);
    for (; unit < NU; unit += F.G) {
        const int g = unit & 15, n = (unit >> 4) & 31, b = unit >> 9, row0 = b * T + n * MIXC;
        if (g != gcur) { gcur = g;
#pragma unroll
            for (int j = 0; j < 4; ++j) { const int idx = F.tid + 512 * j, t = idx >> 4, s8 = (idx & 15) * 8; const float* wp = F.w_s + (size_t)g * 16384 + t * 128 + s8;
                const f32x4 a = *(const GAS f32x4*)wp, c = *(const GAS f32x4*)(wp + 4); v4u o; o.x = pk2(a.x, a.y); o.y = pk2(a.z, a.w); o.z = pk2(c.x, c.y); o.w = pk2(c.z, c.w);
                *(LAS v4u*)(WB + t * 136 + s8) = o; }
            const f32x4 g0 = *(const GAS f32x4*)(F.v_norm_g + g * 128 + c8), g1 = *(const GAS f32x4*)(F.v_norm_g + g * 128 + c8 + 4), b0 = *(const GAS f32x4*)(F.v_norm_b + g * 128 + c8), b1 = *(const GAS f32x4*)(F.v_norm_b + g * 128 + c8 + 4);
            gg[0] = g0.x; gg[1] = g0.y; gg[2] = g0.z; gg[3] = g0.w; gg[4] = g1.x; gg[5] = g1.y; gg[6] = g1.z; gg[7] = g1.w;
            bb[0] = b0.x; bb[1] = b0.y; bb[2] = b0.z; bb[3] = b0.w; bb[4] = b1.x; bb[5] = b1.y; bb[6] = b1.z; bb[7] = b1.w;
#pragma unroll
            for (int tb = 0; tb < 8; ++tb) bs[tb] = F.b_s[g * 128 + 16 * tb + fr]; }
#pragma unroll
        for (int j = 0; j < 4; ++j) { const int sl = (F.tid + 512 * j) >> 4; const v4u wv = vw[j];
            const float x[8] = {bflo(wv.x), bfhi(wv.x), bflo(wv.y), bfhi(wv.y), bflo(wv.z), bfhi(wv.z), bflo(wv.w), bfhi(wv.w)};
            LAS bf16* vp = VN + c8 * 136 + (c8 >> 4) * 8 + sl;
#pragma unroll
            for (int e = 0; e < 8; ++e) vp[e * 136] = (bf16)f2bf((x[e] - mu[j]) * rs[j] * gg[e] + bb[e]); }
        __syncthreads();
        v2u uw[8];
#pragma unroll
        for (int tb = 0; tb < 8; ++tb) uw[tb] = un[tb];
        if (unit + F.G < NU) mix_ld(F, unit + F.G, vw, mu, rs, un);
        bf16x8 af[4];
#pragma unroll
        for (int ks = 0; ks < 4; ++ks) af[ks] = *(const LAS bf16x8*)(VN + (16 * w + fr) * 136 + 8 * w + 32 * ks + 8 * fq);
#pragma unroll
        for (int tb = 0; tb < 8; ++tb) { f32x4 acc = {0.f, 0.f, 0.f, 0.f};
#pragma unroll
            for (int ks = 0; ks < 4; ++ks) acc = MFMA16(af[ks], *(const LAS bf16x8*)(WB + (16 * tb + fr) * 136 + 32 * ks + 8 * fq), acc);
            const int row = row0 + 16 * tb + fr, c0 = g * 128 + 16 * w + 4 * fq;
            v2u yo; yo.x = pk2(bflo(uw[tb].x) * (acc[0] + bs[tb]), bfhi(uw[tb].x) * (acc[1] + bs[tb])); yo.y = pk2(bflo(uw[tb].y) * (acc[2] + bs[tb]), bfhi(uw[tb].y) * (acc[3] + bs[tb]));
            *(GAS v2u*)(Y + pg8::tl_off(row, 2048 + c0, D)) = yo; }
        __syncthreads();
    }
}

__device__ __forceinline__ void ln1_process(Frame& F, int lane, int m, f32x4 (&v)[16], float* stats, bf16* ho) {
    float s = 0.f;
#pragma unroll
    for (int j = 0; j < 16; ++j) s += (v[j].x + v[j].y) + (v[j].z + v[j].w);
    const float mean = wave_sum(s) * (1.f / D); float s2 = 0.f;
#pragma unroll
    for (int j = 0; j < 16; ++j) { const f32x4 d = v[j] - mean; s2 += (d.x * d.x + d.y * d.y) + (d.z * d.z + d.w * d.w); }
    float rstd = 1.f / sqrtf(wave_sum(s2) * (1.f / D) + LN_EPS);
    if (lane == 0) { stats[2 * m] = mean; stats[2 * m + 1] = rstd; }
    const GAS f32x4* g1 = (const GAS f32x4*)opqp(F.ln1_g) + lane; const GAS f32x4* b1 = (const GAS f32x4*)opqp(F.ln1_b) + lane;
#pragma unroll
    for (int j = 0; j < 16; ++j) { v[j] = (v[j] - mean) * rstd * g1[64 * j] + b1[64 * j]; if ((j & 3) == 3) asm volatile("" ::: "memory"); }
    rstd = ln_center(v);
    const float* mod = (const float*)(F.ws + WS_MODX) + (size_t)(m >> 12) * 24576;
    const GAS f32x4* sh = (const GAS f32x4*)opqp(mod + 3 * 4096) + lane; const GAS f32x4* sc = (const GAS f32x4*)opqp(mod + 4 * 4096) + lane;
    float amax = 0.f;
#pragma unroll
    for (int j = 0; j < 16; ++j) { const f32x4 a = sh[64 * j], b = sc[64 * j]; v[j] = v[j] * rstd * (b + 1.0f) + a;
        amax = fmaxf(amax, fmaxf(fmaxf(fabsf(v[j].x), fabsf(v[j].y)), fmaxf(fabsf(v[j].z), fabsf(v[j].w)))); if ((j & 3) == 3) asm volatile("" ::: "memory"); }
    amax = wave_max(amax);
    amax = fmaxf(amax, 1e-20f);
    if (lane == 0) ((float*)(F.ws + WS_SA2))[m] = amax * (1.0f / 127.0f);
    const float inv = 127.0f / amax;
    unsigned char* const ob = (unsigned char*)ho + pg8::tl_off(m, 2 * lane, 2048) * 2;
#pragma unroll
    for (int j = 0; j < 16; ++j) *(GAS unsigned*)(ob + (size_t)j * 2 * 16384 * 2) = pack_i8(v[j].x * inv, v[j].y * inv, v[j].z * inv, v[j].w * inv);
}
__device__ __forceinline__ void ln1_process_l(Frame& F, int lane_, int m, f32x4 (&v)[16], float* stats, bf16* ho, const LAS float* V) {
    const int lane = opq(lane_);
    float s = 0.f;
#pragma unroll
    for (int j = 0; j < 16; ++j) s += (v[j].x + v[j].y) + (v[j].z + v[j].w);
    const float mean = wave_sum(s) * (1.f / D); float s2 = 0.f;
#pragma unroll
    for (int j = 0; j < 16; ++j) { const f32x4 d = v[j] - mean; s2 += (d.x * d.x + d.y * d.y) + (d.z * d.z + d.w * d.w); }
    float rstd = 1.f / sqrtf(wave_sum(s2) * (1.f / D) + LN_EPS);
    if (lane == 0) { stats[2 * m] = mean; stats[2 * m + 1] = rstd; }
    const LAS f32x4* g1 = (const LAS f32x4*)V + lane; const LAS f32x4* b1 = g1 + 1024; const LAS f32x4* sh = g1 + 2048; const LAS f32x4* sc = g1 + 3072;
#pragma unroll
    for (int j = 0; j < 16; ++j) v[j] = (v[j] - mean) * rstd * g1[64 * j] + b1[64 * j];
    rstd = ln_center(v);
    float amax = 0.f;
#pragma unroll
    for (int j = 0; j < 16; ++j) { const f32x4 a = sh[64 * j], b = sc[64 * j]; v[j] = v[j] * rstd * (b + 1.0f) + a;
        amax = fmaxf(amax, fmaxf(fmaxf(fabsf(v[j].x), fabsf(v[j].y)), fmaxf(fabsf(v[j].z), fabsf(v[j].w)))); }
    amax = wave_max(amax);
    amax = fmaxf(amax, 1e-20f);
    if (lane == 0) ((float*)(F.ws + WS_SA2))[m] = amax * (1.0f / 127.0f);
    const float inv = 127.0f / amax;
    unsigned char* const ob = (unsigned char*)ho + pg8::tl_off(m, 2 * lane, 2048) * 2;
#pragma unroll
    for (int j = 0; j < 16; ++j) *(GAS unsigned*)(ob + (size_t)j * 2 * 16384 * 2) = pack_i8(v[j].x * inv, v[j].y * inv, v[j].z * inv, v[j].w * inv);
}
__device__ __forceinline__ void ln1_rows(Frame& F, float* xo, bf16* ho) {
    const int gw = blockIdx.x * NWAVES + F.wave, NGW = F.G * NWAVES; const int lane = opq(F.tid & 63);
    LAS float* V = (LAS float*)(F.lds + RING_OFF);
    for (int i = F.tid; i < 1024; i += NWAVES * 64) { ((LAS f32x4*)V)[i] = ((const GAS f32x4*)F.ln1_g)[i]; ((LAS f32x4*)V)[1024 + i] = ((const GAS f32x4*)F.ln1_b)[i]; }
    f32x4 a[16], b[16];
    for (int seg = 0; seg < 4; ++seg) {
        const int base = seg * 4096, r0 = gw, r1 = gw + NGW;
        if (r0 < 4096) ld_row16(F.out + (size_t)(base + r0) * D, lane, a);
        if (r1 < 4096) ld_row16(F.out + (size_t)(base + r1) * D, lane, b);
        const float* mod = (const float*)(F.ws + WS_MODX) + (size_t)seg * 24576 + 3 * 4096;
        for (int i = F.tid; i < 2048; i += NWAVES * 64) ((LAS f32x4*)V)[2048 + i] = ((const GAS f32x4*)mod)[i];
        __syncthreads();
        for (int r = r0; r < 4096; r += 2 * NGW) {
            if (r != r0) { ld_row16(F.out + (size_t)(base + r) * D, lane, a); if (r + NGW < 4096) ld_row16(F.out + (size_t)(base + r + NGW) * D, lane, b); }
            ln1_process_l(F, lane, base + r, a, xo, ho, V);
            if (r + NGW < 4096) ln1_process_l(F, lane, base + r + NGW, b, xo, ho, V); }
        __syncthreads();
    }
}
__device__ __forceinline__ void ln2_process(Frame& F, int lane, int m, f32x4 (&v)[16], float* xo) {
    const float rstd = ln_center(v);
    const GAS f32x4* g1 = (const GAS f32x4*)opqp(F.ln2_g) + lane; const GAS f32x4* b1 = (const GAS f32x4*)opqp(F.ln2_b) + lane;
    GAS f32x4* xw = (GAS f32x4*)(xo + (size_t)m * D) + lane;
#pragma unroll
    for (int j = 0; j < 16; ++j) xw[64 * j] = v[j] * rstd * g1[64 * j] + b1[64 * j];
}
__device__ __forceinline__ void ln2_rows(Frame& F, float* xo) {
    const int gw = blockIdx.x * NWAVES + F.wave, NGW = F.G * NWAVES;
    f32x4 a[16], b[16]; const int lane = opq(F.tid & 63);
    if (gw < M) ld_row16(F.out + (size_t)gw * D, lane, a);
    for (int m = gw; m < M; m += 2 * NGW) { const int m1 = m + NGW, m2 = m + 2 * NGW;
        if (m1 < M) ld_row16(F.out + (size_t)m1 * D, lane, b);
        ln2_process(F, lane, m, a, xo);
        if (m1 < M) { if (m2 < M) ld_row16(F.out + (size_t)m2 * D, lane, a); ln2_process(F, lane, m1, b, xo); } }
}

constexpr int NPHASE = 12;
struct Args { const float* in[22]; float* out; unsigned char* ws; int ph_lo, ph_hi; };
__global__ void __launch_bounds__(NWAVES * 64, 2) mk_fwd(Args args) {
    extern __shared__ __attribute__((aligned(16))) unsigned char lds[];
    Frame F;
    F.lds = (LAS unsigned char*)lds;
    F.MISC = (volatile LAS unsigned*)(F.lds + MISC_OFF);
    F.tid = threadIdx.x; F.lane = F.tid & 63; F.wave = __builtin_amdgcn_readfirstlane(F.tid >> 6);
    F.G = gridDim.x;
    unsigned char* ws = args.ws; F.ws = ws; F.out = args.out;
    F.ctl = (gu32*)(ws + WS_CTL);
    F.x = args.in[0]; F.c = args.in[1]; F.ctx = args.in[2]; F.c_ctx = args.in[3]; F.w_ada = args.in[4]; F.b_ada = args.in[5]; F.w_in = args.in[6]; F.lbl = args.in[7];
    F.a_norm_g = args.in[8]; F.w_proj_a = args.in[9]; F.v_norm_g = args.in[10]; F.v_norm_b = args.in[11]; F.w_s = args.in[12]; F.b_s = args.in[13]; F.w_proj_b = args.in[14];
    F.w_out = args.in[15]; F.ln1_g = args.in[16]; F.ln1_b = args.in[17]; F.w_ff1 = args.in[18]; F.w_ff2 = args.in[19]; F.ln2_g = args.in[20]; F.ln2_b = args.in[21];
    for (int u = F.tid; u < (LDS_BYTES - LDSCTL_OFF) / 4; u += NWAVES * 64) ((LAS unsigned*)(F.lds + LDSCTL_OFF))[u] = 0u;
    __syncthreads();
    const int lo = args.ph_lo, hi = args.ph_hi;
    XcdBarrier bar; bar.bar = (unsigned*)(F.ctl + CW_BAR); bar.x = 0; bar.st = nullptr;
    if (hi - lo > 1) bar = xcd_barrier_post((unsigned*)(F.ctl + CW_BAR), F.MISC + 8);
#define IN(k) (lo <= (k) && (k) < hi)
#define SEAM(k) do { if (IN(k) && IN((k) + 1)) xcd_barrier(bar); } while (0)
    bf16* const P = (bf16*)(ws + WS_P);
    bf16* const HB = (bf16*)(ws + WS_HBUF);
    bf16* const Y = (bf16*)(ws + WS_Y);
    const float* const MODX = (const float*)(ws + WS_MODX);

    if (IN(0)) { REPS(0) { p0_prologue(F); __syncthreads(); } } SEAM(0);
    if (IN(1)) { REPS(1) p1_rows(F); } SEAM(1);
    if (IN(2)) {
        if constexpr (!I8_U) { pg8::Gemm g{pg8::tiled(HB, D), pg8::tiled((const bf16*)(ws + WS_WINB), D), D}; pg8::StaticOrder S; S.init(M / 256, I8_GV ? 8 : 24, F.G, (int)blockIdx.x); S.pnoff = I8_GV ? 8 : 0;
          pg8::EpiInProj E{P};
          pg8::gemm_phase<pg8::EpiInProj, pg8::StaticOrder, PG8_ALIGN, PG8_SP2>(F.lds + RING_OFF, g, S, E); }
        { pg8::Gemm g{pg8::tiled((const bf16*)(ws + WS_H8), 2048), pg8::tiled((const bf16*)(ws + WS_WIN8), 2048), 2048}; pg8::StaticOrder S; S.init(M / 256, 64 + I8_GV * 16 + I8_U * 8 - FP8_T0, F.G, (int)blockIdx.x, MC / 256, 24); S.pnoff = FP8_T0; S.expn0 = 8;
          pg8::EpiInProj8 E{P, (const LAS float*)(F.lds + LDSCTL_OFF + 8192)}; pg8::MidScales MS{(const float*)(ws + WS_SA1), (const float*)(ws + WS_SB0), F.lds + LDSCTL_OFF + 8192};
          pg8::gemm_phase<pg8::EpiInProj8, pg8::StaticOrder, PG8_ALIGN, PG8_SP2, pg8::MidScales, 2>(F.lds + RING_OFF, g, S, E, MS); }
    } SEAM(2);
#if PROBE_DUP == 20
    if (IN(2) && IN(3)) { for (int q = 0; q < 20; ++q) xcd_barrier(bar); }
#endif
    if (IN(3)) { vb_stats_rows(F); } SEAM(3);
    if (IN(4)) {
        chunkmix_phase(F);
        scanA_phase(F, 0);
        if (hi - lo > 1) xcd_barrier(bar);
        scanB(F, 0);
        if (hi - lo > 1) xcd_barrier(bar);
        scanC_phase(F, 0);
        if (hi - lo > 1) xcd_barrier(bar);
        scanA_phase(F, 1);
        if (hi - lo > 1) xcd_barrier(bar);
        scanB(F, 1);
        if (hi - lo > 1) xcd_barrier(bar);
        scanC_phase(F, 1);
    }
    if (IN(4) && IN(6)) xcd_barrier(bar);
    if (IN(6)) {
        pg8::StaticOrder S; S.init(M / 256, D / 256, F.G, (int)blockIdx.x);
        const bf16* PG = P + 4 * pg8::SZ4 + 3 * pg8::SZ3;
        pg8::Gemm g{pg8::tiled(Y, D), pg8::tiled((const bf16*)(ws + WS_WPAB), D), D}; pg8::EpiMerge<false> E{PG, 1, HB}; pg8::MidRatio MH{PG};
        pg8::gemm_phase<pg8::EpiMerge<false>, pg8::StaticOrder, PG8_ALIGN, PG8_SP2, pg8::MidRatio>(F.lds + RING_OFF, g, S, E, MH);
    } SEAM(6);
    if (IN(7)) {
        pg8::Gemm g{pg8::tiled(HB, D), pg8::tiled((const bf16*)(ws + WS_WOUT), D), D}; pg8::StaticOrder S; S.init(M / 256, D / 256, F.G, (int)blockIdx.x);
#if PROBE_DUP == 7
        { pg8::EpiResid<1> E0{F.x, MODX + 2 * 4096, ALPHA, (float*)(ws + WS_ABUF), (const float*)(ws + WS_ETAB), nullptr, nullptr, nullptr}; pg8::gemm_phase<pg8::EpiResid<1>, pg8::StaticOrder, PG8_ALIGN, PG8_SP2>(F.lds + RING_OFF, g, S, E0); }
#endif
        pg8::EpiResid<1> E{F.x, MODX + 2 * 4096, ALPHA, F.out, (const float*)(ws + WS_ETAB), nullptr, nullptr, nullptr};
        pg8::gemm_phase<pg8::EpiResid<1>, pg8::StaticOrder, PG8_ALIGN, PG8_SP2>(F.lds + RING_OFF, g, S, E);
    } SEAM(7);
    if (IN(8)) {
#if PROBE_DUP == 8
        ln1_rows(F, (float*)(ws + WS_WOUT), (bf16*)(ws + WS_Y));
#endif
        ln1_rows(F, (float*)(ws + WS_ST1), HB); REPS(15) ff_weight_copies(F); } SEAM(8);
    if (IN(9)) {
        pg8::Gemm g{pg8::tiled(HB, 2048), pg8::tiled((const bf16*)(ws + WS_WFF1), 2048), 2048}; pg8::StaticOrder S; S.init(M / 256, DFF / 256, F.G, (int)blockIdx.x);
        pg8::EpiRelu2Q E{(bf16*)(ws + WS_ABUF), DFF, (const LAS float*)(F.lds + LDSCTL_OFF + 8192)}; pg8::MidScales MS{(const float*)(ws + WS_SA2), (const float*)(ws + WS_SB1), F.lds + LDSCTL_OFF + 8192};
        pg8::gemm_phase<pg8::EpiRelu2Q, pg8::StaticOrder, PG8_ALIGN, PG8_SP2, pg8::MidScales, 2>(F.lds + RING_OFF, g, S, E, MS);
    } SEAM(9);
    if (IN(10)) {
        pg8::Gemm g{pg8::tiled((const bf16*)(ws + WS_ABUF), DFF), pg8::tiled((const bf16*)(ws + WS_WFF2), DFF), DFF}; pg8::StaticOrder S; S.init(M / 256, D / 256, F.G, (int)blockIdx.x, 0, 0, FF2_WGM);
#if PROBE_DUP == 10
        { pg8::EpiResid<2> E0{F.out, MODX + 5 * 4096, ALPHA, (float*)(ws + WS_WIN), nullptr, (const float*)(ws + WS_ST1), F.ln1_g, F.ln1_b}; pg8::gemm_phase<pg8::EpiResid<2>, pg8::StaticOrder, PG8_ALIGN, PG8_SP2>(F.lds + RING_OFF, g, S, E0); }
#endif
        pg8::EpiResidLn E{F.out, ALPHA, F.out, (const LAS float*)(F.lds + LDSCTL_OFF + 8192)}; pg8::MidLn ML{MODX + 5 * 4096, F.ln1_g, F.ln1_b, (const float*)(ws + WS_ST1), F.lds + LDSCTL_OFF + 8192};
        pg8::gemm_phase<pg8::EpiResidLn, pg8::StaticOrder, PG8_ALIGN, PG8_SP2, pg8::MidLn>(F.lds + RING_OFF, g, S, E, ML);
    } SEAM(10);
    if (IN(11)) {
#if PROBE_DUP == 11
        ln2_rows(F, (float*)(ws + WS_WIN));
#endif
        ln2_rows(F, F.out);
#if PROBE_DUP == 21
        xcd_barrier(bar); p0_prologue(F);
#endif
    }
#undef IN
#undef SEAM
}

extern "C" void kernel_launch(void* const* d_in, const int* in_sizes, int n_in, void* d_out, int out_size, void* d_ws, size_t ws_size, hipStream_t stream) {
    static int grid = 0;
    if (grid == 0) {
        if (n_in != 22 || in_sizes[0] != M * D || out_size != M * D || ws_size < WS_END) { fprintf(stderr, "kernel_launch: unexpected shapes (n_in %d, in0 %d, out %d, ws %zu < %zu); nothing launched\n", n_in, n_in > 0 ? in_sizes[0] : -1, out_size, ws_size, (size_t)WS_END); grid = -1; return; }
        int dev = 0, cus = 0, per_cu = 0;
        if (hipGetDevice(&dev) != hipSuccess || hipDeviceGetAttribute(&cus, hipDeviceAttributeMultiprocessorCount, dev) != hipSuccess) { grid = -1; return; }
        if (hipFuncSetAttribute((const void*)mk_fwd, hipFuncAttributeMaxDynamicSharedMemorySize, LDS_BYTES) != hipSuccess) { fprintf(stderr, "kernel_launch: hipFuncSetAttribute failed\n"); grid = -1; return; }
        if (hipOccupancyMaxActiveBlocksPerMultiprocessor(&per_cu, (const void*)mk_fwd, NWAVES * 64, LDS_BYTES) != hipSuccess || per_cu < 1) { fprintf(stderr, "kernel_launch: occupancy query reports %d blocks per CU\n", per_cu); }
        (void)hipGetLastError();
        grid = cus;
    }
    if (grid < 0) return;
    if (hipMemsetAsync((char*)d_ws + WS_CTL, 0, CTL_ZERO_BYTES, stream) != hipSuccess) { fprintf(stderr, "kernel_launch: memset failed\n"); return; }
    Args a{};
    for (int i = 0; i < 22; ++i) a.in[i] = (const float*)d_in[i];
    a.out = (float*)d_out; a.ws = (unsigned char*)d_ws;
#if MK_N_LAUNCHES == 1
    a.ph_lo = 0; a.ph_hi = NPHASE;
    hipLaunchKernelGGL(mk_fwd, dim3(grid), dim3(NWAVES * 64), LDS_BYTES, stream, a);
#else
    for (int p = 0; p < NPHASE; ++p) { a.ph_lo = p; a.ph_hi = p + 1; hipLaunchKernelGGL(mk_fwd, dim3(grid), dim3(NWAVES * 64), LDS_BYTES, stream, a); }
#endif
    const hipError_t le = hipPeekAtLastError();
    if (le != hipSuccess) fprintf(stderr, "kernel_launch: launch failed: %s\n", hipGetErrorName(le));
}
```
